# Optimizing an MI355X kernel written in HIP

```python
import jax, jax.numpy as jnp
from jax import lax
import numpy as np

D_MODEL = 4096
BATCH = 1
SEQ = 8192
DEPTH = 1
DEC_BATCH = 16
DEC_SEQ = 16
PAST_LEN = 1024

CHUNK = 64
Q_BLOCK = 128
SPARSE_Q_BLOCK = 64
EPS = 1e-6
NEG = -1e30

MLA_HEADS = D_MODEL // 128
MLA_Q_LORA = D_MODEL // 4
MLA_KV_LORA = 512
MLA_NOPE = 128
MLA_ROPE = 64
MLA_V = 128
MLA_THETA = 10000.0
MLA_SCALE = (MLA_NOPE + MLA_ROPE) ** -0.5

DSA_HEADS = D_MODEL // 128
DSA_KV_HEADS = DSA_HEADS // 4
DSA_HEAD_DIM = 128
DSA_ROT = DSA_HEAD_DIM // 4
DSA_SCALE = DSA_HEAD_DIM ** -0.5
IDX_HEADS = D_MODEL // 128
IDX_DIM = 128
IDX_ROT = IDX_DIM // 4
IDX_W_SCALE = IDX_HEADS ** -0.5
TOPK_MAX = 256
ROPE_THETA = 500000.0

D_FF = 4 * D_MODEL
N_ADA = 6

IN_SPLITS = (MLA_Q_LORA, MLA_KV_LORA, MLA_ROPE,
             DSA_HEADS * DSA_HEAD_DIM, DSA_KV_HEADS * DSA_HEAD_DIM, DSA_KV_HEADS * DSA_HEAD_DIM,
             IDX_HEADS * IDX_DIM, IDX_DIM, IDX_HEADS,
             D_MODEL, D_MODEL)
D_IN = sum(IN_SPLITS)

kernel_name = 'hybrid_mla_dsa_streaming_encoder_step'


def rmsnorm(x, g):
    xf = x.astype(jnp.float32)
    y = xf * lax.rsqrt(jnp.mean(xf * xf, axis=-1, keepdims=True) + EPS)
    return (y * g.astype(jnp.float32)).astype(x.dtype)


def rope(x, pos, theta, rot_dim):
    half = rot_dim // 2
    inv = theta ** (-jnp.arange(half, dtype=jnp.float32) / half)
    ang = pos.astype(jnp.float32)[:, None] * inv[None, :]
    ang = ang.reshape(ang.shape[0], *([1] * (x.ndim - 3)), half)
    cos = jnp.cos(ang).astype(x.dtype)
    sin = jnp.sin(ang).astype(x.dtype)
    x1, x2, rest = x[..., :half], x[..., half:rot_dim], x[..., rot_dim:]
    return jnp.concatenate([x1 * cos - x2 * sin, x2 * cos + x1 * sin, rest], axis=-1)


def chunk_mask(q_pos, k_pos):
    return (k_pos[None, :] // CHUNK) <= (q_pos[:, None] // CHUNK)


def split_cols(z):
    offsets = [int(o) for o in np.cumsum(IN_SPLITS)[:-1]]
    return jnp.split(z, offsets, axis=-1)


def sweep_blocks(fn, block, q_pos, *qs):
    T = q_pos.shape[0]
    if T <= block:
        return fn(q_pos, *qs)
    nb = T // block
    qb = tuple(jnp.moveaxis(q.reshape(q.shape[0], nb, block, *q.shape[2:]), 1, 0) for q in qs)
    pb = q_pos.reshape(nb, block)
    out = lax.map(lambda a: fn(*a), (pb,) + qb)
    out = jnp.moveaxis(out, 0, 1)
    return out.reshape(out.shape[0], T, *out.shape[3:])


def mla_attend(q_pos, q_lat, q_rope, ckv_all, krope_all, k_pos):
    s = (jnp.einsum('bthc,blc->bhtl', q_lat, ckv_all)
         + jnp.einsum('bthr,blr->bhtl', q_rope, krope_all)).astype(jnp.float32) * MLA_SCALE
    s = jnp.where(chunk_mask(q_pos, k_pos)[None, None], s, NEG)
    p = jax.nn.softmax(s, axis=-1).astype(ckv_all.dtype)
    return jnp.einsum('bhtl,blc->bthc', p, ckv_all)


def dsa_attend(q_pos, q, qi, wi, k_all, v_all, ki_all, k_pos, topk):
    f32 = jnp.float32
    adm = chunk_mask(q_pos, k_pos)
    rel = jax.nn.relu(jnp.einsum('bthd,bld->bthl', qi, ki_all).astype(f32))
    score = jnp.einsum('bth,bthl->btl', wi.astype(f32) * IDX_W_SCALE, rel)
    score = jnp.where(adm[None], score, NEG)
    _, sel = lax.top_k(score, topk)
    valid = (k_pos[sel] // CHUNK) <= (q_pos[None, :, None] // CHUNK)
    kg = jax.vmap(lambda kb, sb: kb[sb])(k_all, sel)
    vg = jax.vmap(lambda vb, sb: vb[sb])(v_all, sel)
    B, T, H, D = q.shape
    qg = q.reshape(B, T, DSA_KV_HEADS, H // DSA_KV_HEADS, D)
    s = jnp.einsum('btgrd,btkgd->btgrk', qg, kg).astype(f32) * DSA_SCALE
    s = jnp.where(valid[:, :, None, None, :], s, NEG)
    p = jax.nn.softmax(s, axis=-1).astype(v_all.dtype)
    o = jnp.einsum('btgrk,btkgd->btgrd', p, vg)
    return o.reshape(B, T, H * D)


def encoder_layer(x, c, past, q_pos, k_pos, topk,
                  w_ada, b_ada, g_norm1, w_in, g_q_lora, w_uq, g_kv_lora, w_uk, w_uv,
                  w_out, g_norm2, w_up, w_down):
    B, T, _ = x.shape
    ada = jnp.einsum('bd,de->be', jax.nn.silu(c), w_ada) + b_ada
    sh1, sc1, gt1, sh2, sc2, gt2 = jnp.split(ada[:, None, :], N_ADA, axis=-1)

    h = rmsnorm(x, g_norm1) * (1.0 + sc1) + sh1
    z = jnp.einsum('btd,de->bte', h, w_in)
    (q_lat_in, ckv, krope, q_b, k_b, v_b, qi, ki, wi, gate_a, gate_b) = split_cols(z)

    q_a = jnp.einsum('btc,ce->bte', rmsnorm(q_lat_in, g_q_lora), w_uq)
    q_a = q_a.reshape(B, T, MLA_HEADS, MLA_NOPE + MLA_ROPE)
    q_nope = q_a[..., :MLA_NOPE]
    q_rope = rope(q_a[..., MLA_NOPE:], q_pos, MLA_THETA, MLA_ROPE)
    ckv = rmsnorm(ckv, g_kv_lora)
    krope = rope(krope, q_pos, MLA_THETA, MLA_ROPE)
    q_lat = jnp.einsum('bthn,chn->bthc', q_nope, w_uk)

    q_b = rope(q_b.reshape(B, T, DSA_HEADS, DSA_HEAD_DIM), q_pos, ROPE_THETA, DSA_ROT)
    k_b = rope(k_b.reshape(B, T, DSA_KV_HEADS, DSA_HEAD_DIM), q_pos, ROPE_THETA, DSA_ROT)
    v_b = v_b.reshape(B, T, DSA_KV_HEADS, DSA_HEAD_DIM)
    qi = rope(qi.reshape(B, T, IDX_HEADS, IDX_DIM), q_pos, ROPE_THETA, IDX_ROT)
    ki = rope(ki, q_pos, ROPE_THETA, IDX_ROT)

    if past is None:
        ckv_all, krope_all, k_all, v_all, ki_all = ckv, krope, k_b, v_b, ki
    else:
        p_ckv, p_krope, p_k, p_v, p_ki = past
        ckv_all = jnp.concatenate([p_ckv, ckv], axis=1)
        krope_all = jnp.concatenate([p_krope, krope], axis=1)
        k_all = jnp.concatenate([p_k, k_b], axis=1)
        v_all = jnp.concatenate([p_v, v_b], axis=1)
        ki_all = jnp.concatenate([p_ki, ki], axis=1)

    o_lat = sweep_blocks(lambda p, ql, qr: mla_attend(p, ql, qr, ckv_all, krope_all, k_pos),
                         Q_BLOCK, q_pos, q_lat, q_rope)
    out_a = jnp.einsum('bthc,chv->bthv', o_lat, w_uv).reshape(B, T, MLA_HEADS * MLA_V)
    out_b = sweep_blocks(lambda p, qq, qqi, wwi: dsa_attend(p, qq, qqi, wwi, k_all, v_all, ki_all, k_pos, topk),
                         SPARSE_Q_BLOCK, q_pos, q_b, qi, wi)

    merged = jax.nn.sigmoid(gate_a) * out_a + jax.nn.sigmoid(gate_b) * out_b
    x = x + gt1 * jnp.einsum('btd,de->bte', merged, w_out)

    h2 = rmsnorm(x, g_norm2) * (1.0 + sc2) + sh2
    u = jax.nn.relu(jnp.einsum('btd,df->btf', h2, w_up))
    x = x + gt2 * jnp.einsum('btf,fd->btd', u * u, w_down)
    return x, (ckv, krope, k_b, v_b, ki)


def setup_inputs(seed: int = 0) -> dict:
    key = jax.random.key(seed)
    ks = jax.random.split(key, 23)
    f32 = jnp.float32

    def nrm(k, shape, scale=1.0):
        return jax.random.normal(k, shape, f32) * scale

    def gain(k, shape):
        return 1.0 + 0.02 * jax.random.normal(k, shape, f32)

    return {
        'x_prompt': nrm(ks[0], (BATCH, SEQ, D_MODEL)),
        'x_sample': nrm(ks[1], (DEC_BATCH, DEC_SEQ, D_MODEL)),
        'c_prompt': nrm(ks[2], (BATCH, D_MODEL)),
        'c_sample': nrm(ks[3], (DEC_BATCH, D_MODEL)),
        'cache_mla_ckv': nrm(ks[4], (DEPTH, DEC_BATCH, PAST_LEN, MLA_KV_LORA)),
        'cache_mla_krope': nrm(ks[5], (DEPTH, DEC_BATCH, PAST_LEN, MLA_ROPE)),
        'cache_dsa_k': nrm(ks[6], (DEPTH, DEC_BATCH, PAST_LEN, DSA_KV_HEADS, DSA_HEAD_DIM)),
        'cache_dsa_v': nrm(ks[7], (DEPTH, DEC_BATCH, PAST_LEN, DSA_KV_HEADS, DSA_HEAD_DIM)),
        'cache_idx_k': nrm(ks[8], (DEPTH, DEC_BATCH, PAST_LEN, IDX_DIM)),
        'w_ada': nrm(ks[9], (DEPTH, D_MODEL, N_ADA * D_MODEL), 0.5 * D_MODEL ** -0.5),
        'b_ada': nrm(ks[10], (DEPTH, N_ADA * D_MODEL), 0.02),
        'g_norm1': gain(ks[11], (DEPTH, D_MODEL)),
        'w_in': nrm(ks[12], (DEPTH, D_MODEL, D_IN), D_MODEL ** -0.5),
        'g_q_lora': gain(ks[13], (DEPTH, MLA_Q_LORA)),
        'w_uq': nrm(ks[14], (DEPTH, MLA_Q_LORA, MLA_HEADS * (MLA_NOPE + MLA_ROPE)), MLA_Q_LORA ** -0.5),
        'g_kv_lora': gain(ks[15], (DEPTH, MLA_KV_LORA)),
        'w_uk': nrm(ks[16], (DEPTH, MLA_KV_LORA, MLA_HEADS, MLA_NOPE), MLA_KV_LORA ** -0.5),
        'w_uv': nrm(ks[17], (DEPTH, MLA_KV_LORA, MLA_HEADS, MLA_V), MLA_KV_LORA ** -0.5),
        'w_out': nrm(ks[18], (DEPTH, D_MODEL, D_MODEL), D_MODEL ** -0.5),
        'g_norm2': gain(ks[19], (DEPTH, D_MODEL)),
        'w_up': nrm(ks[20], (DEPTH, D_MODEL, D_FF), D_MODEL ** -0.5),
        'w_down': nrm(ks[21], (DEPTH, D_FF, D_MODEL), D_FF ** -0.5),
        'g_final': gain(ks[22], (D_MODEL,)),
    }


def reference(x_prompt, x_sample, c_prompt, c_sample,
              cache_mla_ckv, cache_mla_krope, cache_dsa_k, cache_dsa_v, cache_idx_k,
              w_ada, b_ada, g_norm1, w_in, g_q_lora, w_uq, g_kv_lora, w_uk, w_uv,
              w_out, g_norm2, w_up, w_down, g_final):
    topk_prompt = min(TOPK_MAX, SEQ // 4)
    topk_sample = min(TOPK_MAX, (PAST_LEN + DEC_SEQ) // 4)
    pos_prompt = jnp.arange(SEQ, dtype=jnp.int32)
    pos_sample_q = PAST_LEN + jnp.arange(DEC_SEQ, dtype=jnp.int32)
    pos_sample_k = jnp.arange(PAST_LEN + DEC_SEQ, dtype=jnp.int32)

    xp, xs = x_prompt, x_sample
    rows_p, rows_s = [], []
    for l in range(DEPTH):
        lw = (w_ada[l], b_ada[l], g_norm1[l], w_in[l], g_q_lora[l], w_uq[l], g_kv_lora[l],
              w_uk[l], w_uv[l], w_out[l], g_norm2[l], w_up[l], w_down[l])
        xp, rp = encoder_layer(xp, c_prompt, None, pos_prompt, pos_prompt, topk_prompt, *lw)
        past = (cache_mla_ckv[l], cache_mla_krope[l], cache_dsa_k[l], cache_dsa_v[l], cache_idx_k[l])
        xs, rs = encoder_layer(xs, c_sample, past, pos_sample_q, pos_sample_k, topk_sample, *lw)
        rows_p.append(rp)
        rows_s.append(rs)

    y_prompt = rmsnorm(xp, g_final)
    y_sample = rmsnorm(xs, g_final)
    new_ckv_prompt = jnp.stack([r[0] for r in rows_p])
    new_krope_prompt = jnp.stack([r[1] for r in rows_p])
    new_k_prompt = jnp.stack([r[2] for r in rows_p])
    new_v_prompt = jnp.stack([r[3] for r in rows_p])
    new_idxk_prompt = jnp.stack([r[4] for r in rows_p])
    new_ckv_sample = jnp.stack([r[0] for r in rows_s])
    new_krope_sample = jnp.stack([r[1] for r in rows_s])
    new_k_sample = jnp.stack([r[2] for r in rows_s])
    new_v_sample = jnp.stack([r[3] for r in rows_s])
    new_idxk_sample = jnp.stack([r[4] for r in rows_s])
    return (y_prompt, y_sample,
            new_ckv_prompt, new_krope_prompt, new_k_prompt, new_v_prompt, new_idxk_prompt,
            new_ckv_sample, new_krope_sample, new_k_sample, new_v_sample, new_idxk_sample)
```

```cpp
#include <hip/hip_runtime.h>
#include <cstdio>
#include <cstdint>

#ifndef MK_N_LAUNCHES
#define MK_N_LAUNCHES 1
#endif

constexpr int DM = 4096, SEQ = 8192, NSAMP = 256, NROW = SEQ + NSAMP;
constexpr int DEC_B = 16, DEC_S = 16, PAST = 1024, SKEYS = PAST + DEC_S, SPITCH = 1088;
constexpr int KROWS = SEQ + DEC_B * SPITCH;
constexpr int DIN = 20192, DINP = 20224, DFF = 16384, NADA = 6 * DM, NVEC = 1 + DEC_B;
constexpr int NH = 32, QLORA = 1024, KVLORA = 512, ROPE_M = 64, NKV = 8;
constexpr float EPS = 1e-6f;
constexpr float LOG2E = 1.4426950408889634f;
constexpr float C_MLA = 0.07216878364870322f * LOG2E;
constexpr float C_DSA = 0.08838834764831845f * LOG2E;
constexpr float IDX_W_SCALE = 0.17677669529663687f;

enum { I_XP = 0, I_XS, I_CP, I_CS, I_CCKV, I_CKROPE, I_CK, I_CV, I_CKI, I_WADA, I_BADA, I_G1, I_WIN, I_GQ, I_WUQ, I_GKV, I_WUK, I_WUV, I_WOUT, I_G2, I_WUP, I_WDOWN, I_GF, N_IN };
constexpr size_t O_Y = 0, O_CKV_P = 34603008, O_KROPE_P = 38797312, O_K_P = 39321600, O_V_P = 47710208, O_KI_P = 56098816,
                 O_CKV_S = 57147392, O_KROPE_S = 57278464, O_K_S = 57294848, O_V_S = 57556992, O_KI_S = 57819136, O_END = 57851904;

constexpr size_t MiB = 1u << 20;
constexpr size_t WS_CTL = 0, CTL_ZERO_BYTES = 4 * MiB;
constexpr size_t WS_ADA = 1 * MiB;
constexpr size_t WS_ROPE = 4 * MiB;
constexpr size_t WS_WI = 7 * MiB;
constexpr size_t WS_MASK = 9 * MiB;
constexpr size_t WS_WOUT = 18 * MiB, WS_WUP = 50 * MiB, WS_WDOWN = 178 * MiB, WS_WIN = 306 * MiB, WS_WUQ = 464 * MiB, WS_WUKV = 476 * MiB;
constexpr size_t WS_QN = WS_WIN, WS_QAN = WS_WIN + 17 * MiB, WS_QAR = WS_WIN + 83 * MiB;
constexpr size_t WS_XN = 484 * MiB;
constexpr size_t WS_CKV = 550 * MiB, WS_KROPE = 575 * MiB, WS_KALL = 579 * MiB, WS_VALL = 629 * MiB, WS_KI = 679 * MiB;
constexpr size_t WS_QB = 686 * MiB, WS_QI = 752 * MiB, WS_SGA = 818 * MiB, WS_SGB = 884 * MiB;
constexpr size_t WS_MERGED = WS_QI;
constexpr size_t WS_KN = 950 * MiB, WS_VM = 1150 * MiB;
constexpr size_t WS_U = WS_KN;
constexpr size_t WS_SLAB = WS_VM + 64 * MiB;
constexpr int SPLIT_OUT = 8, SPLIT_DOWN = 16;
constexpr size_t WS_OUTA = 1350 * MiB;
constexpr size_t WS_QRAW = 1416 * MiB, WS_CKVRAW = 1449 * MiB;
constexpr size_t WS_SCORE = WS_QRAW;
__host__ __device__ constexpr int score_pitch(int c) { return c < 16 ? 1024 : c < 32 ? 2048 : c < 64 ? 4096 : 8192; }
__host__ __device__ constexpr size_t score_chunk_off(int c) { return c < 16 ? (size_t)c * 65536 : c < 32 ? (size_t)1048576 + (size_t)(c - 16) * 131072 : c < 64 ? (size_t)3145728 + (size_t)(c - 32) * 262144 : (size_t)11534336 + (size_t)(c - 64) * 524288; }
constexpr size_t SCORE_P_FLOATS = score_chunk_off(128);
constexpr int SPITCH_SC = 2048;
constexpr size_t WS_END = WS_SCORE + (SCORE_P_FLOATS + (size_t)NSAMP * SPITCH_SC) * 4;
static_assert(WS_WIN + (size_t)DINP * DM * 2 <= WS_WUQ && WS_QAR + (size_t)NROW * 2048 * 2 <= WS_WUQ, "ws map 1");
static_assert(WS_KN + (size_t)KROWS * 4096 * 2 <= WS_VM && WS_VM + (size_t)KROWS * 4096 * 2 <= WS_OUTA && WS_U + (size_t)NROW * DFF * 2 <= WS_OUTA, "ws map 2");
static_assert(WS_MASK + (size_t)NROW * 128 * 8 <= WS_WOUT && WS_ADA + (size_t)NVEC * NADA * 4 <= CTL_ZERO_BYTES, "ws map 3");
constexpr int CW_TMO = 0, CW_BAR = 4096;

constexpr int RING_BYTES = 131072;
constexpr int LDSCTL_OFF = RING_BYTES, MISC_OFF = LDSCTL_OFF + 320;
constexpr int LDS_BYTES = 147456;

#define GAS __attribute__((address_space(1)))
#define LAS __attribute__((address_space(3)))
typedef unsigned short bf16;
typedef unsigned v4u __attribute__((ext_vector_type(4)));
typedef unsigned v2u __attribute__((ext_vector_type(2)));
typedef float v4f __attribute__((ext_vector_type(4)));
typedef GAS unsigned gu32;
#define RLX_AGENT __ATOMIC_RELAXED, __HIP_MEMORY_SCOPE_AGENT
#define LDS_WAIT() asm volatile("s_waitcnt lgkmcnt(0)" ::: "memory")
#define VM_WAIT() asm volatile("s_waitcnt vmcnt(0)" ::: "memory")
__device__ __forceinline__ unsigned f2bf(float f) { unsigned u = __builtin_bit_cast(unsigned, f); return (u + 0x7fffu + ((u >> 16) & 1u)) >> 16; }
__device__ __forceinline__ unsigned pk2(float lo, float hi) { return f2bf(lo) | (f2bf(hi) << 16); }
__device__ __forceinline__ float bf2f(unsigned short b) { return __builtin_bit_cast(float, (unsigned)b << 16); }
__device__ __forceinline__ float wave_sum(float v) {
#pragma unroll
    for (int o = 1; o < 64; o <<= 1) v += __shfl_xor(v, o);
    return v;
}
__device__ __forceinline__ int row_vec(int r) { return r < SEQ ? 0 : 1 + ((r - SEQ) >> 4); }
__device__ __forceinline__ int row_key(int r) { return r < SEQ ? r : SEQ + ((r - SEQ) >> 4) * SPITCH + PAST + (r & 15); }
__device__ __forceinline__ int row_pos(int r) { return r < SEQ ? r : PAST + (r & 15); }

namespace pg8 {
#define PG8_LAS __attribute__((address_space(3)))
typedef unsigned short bf16_t;
typedef short bf16x8 __attribute__((ext_vector_type(8)));
typedef float f32x4 __attribute__((ext_vector_type(4)));
typedef unsigned u32x4 __attribute__((ext_vector_type(4)));
constexpr int BM = 256, BK = 64, HALF = 128, HTB = HALF * BK * 2  , STAGE_BYTES = 8 * HTB, NXCD = 8, WGM = 8;

__host__ __device__ __forceinline__ int lds_byte(int r, int c) { const int st = (r >> 4) * 2 + (c >> 5), rr = r & 15, cc = c & 31, ob = rr * 64 + cc * 2; return st * 1024 + (ob ^ (((ob >> 9) & 1) << 5)); }
__host__ __device__ __forceinline__ void stage_rc(int b, int& R, int& C) { const int st = b / 1024, sb = b % 1024, swz = sb ^ (((sb >> 9) & 1) << 5); R = (st >> 1) * 16 + swz / 64; C = (st & 1) * 32 + (swz % 64) / 2; }
__host__ __device__ __forceinline__ int perm32(int rho) { const int n = rho >> 4, i = rho & 15; return 8 * (i >> 2) + 4 * n + (i & 3); }

struct Unit { int pm, pn, k0, nt, sp, hf; };
struct Gemm { const bf16_t* A; const bf16_t* Bt; int M, N, K; };

struct StaticOrder {
    int nM, nN, nwg, G, c, lim;
    __host__ __device__ void init(int M, int N, int G_, int c_) { nM = M / BM; nN = N / BM; nwg = nM * nN; G = G_; c = c_; lim = nwg; }
    __host__ __device__ __forceinline__ bool next(int i, Unit& u) const {
        const long L = (long)i * G + c; if (L >= lim) return false;
        int wgid = (int)L; { const int q = nwg / NXCD, r = nwg % NXCD, xcd = wgid % NXCD, off = wgid / NXCD; wgid = (xcd < r ? xcd * (q + 1) : r * (q + 1) + (xcd - r) * q) + off; }
        const int nig = WGM * nN, gid = wgid / nig, fm = gid * WGM, gsz = (nM - fm) < WGM ? (nM - fm) : WGM;
        u.pm = fm + ((wgid % nig) % gsz); u.pn = (wgid % nig) / gsz; u.k0 = 0; u.nt = 0; u.sp = -1; u.hf = 0; return true;
    }
    __device__ __forceinline__ void a_ready(const Unit&) const {}
    __device__ __forceinline__ void done(const Unit&) const {}
};

struct TailHalfOrder {
    int nM, nN, nwg, G, c, nfull;
    __host__ __device__ void init(int M, int N, int G_, int c_) { nM = M / BM; nN = N / BM; nwg = nM * nN; G = G_; c = c_; nfull = (nwg / G) * G; }
    __host__ __device__ __forceinline__ bool next(int i, Unit& u) const {
        const long s_ = (long)i * G + c; if (s_ >= 2L * (nwg - nfull)) return false;
        int wgid = nfull + (int)(s_ >> 1); { const int q = nwg / NXCD, r = nwg % NXCD, xcd = wgid % NXCD, off = wgid / NXCD; wgid = (xcd < r ? xcd * (q + 1) : r * (q + 1) + (xcd - r) * q) + off; }
        const int nig = WGM * nN, gid = wgid / nig, fm = gid * WGM, gsz = (nM - fm) < WGM ? (nM - fm) : WGM;
        u.pm = fm + ((wgid % nig) % gsz); u.pn = (wgid % nig) / gsz; u.k0 = 0; u.nt = 0; u.sp = -1; u.hf = (int)(s_ & 1); return true;
    }
    __device__ __forceinline__ void a_ready(const Unit&) const {}
    __device__ __forceinline__ void done(const Unit&) const {}
};

struct SampleSplitOrder {
    int nMp, nN, nwg, S, ntk, G, c;
    __host__ __device__ void init(int Mp, int N, int K, int S_, int G_, int c_) { nMp = Mp / BM; nN = N / BM; nwg = nMp * nN; S = S_; ntk = K / BK; G = G_; c = c_; }
    __host__ __device__ __forceinline__ bool next(int i, Unit& u) const {
        const long L = (long)i * G + c; int pm, pn, k0 = 0, nt = 0, sp = -1; bool ok = true;
        if (L < nwg) {
            int wgid = (int)L; { const int q = nwg / NXCD, r = nwg % NXCD, xcd = wgid % NXCD, off = wgid / NXCD; wgid = (xcd < r ? xcd * (q + 1) : r * (q + 1) + (xcd - r) * q) + off; }
            const int nig = WGM * nN, gid = wgid / nig, fm = gid * WGM, gsz = (nMp - fm) < WGM ? (nMp - fm) : WGM;
            pm = fm + ((wgid % nig) % gsz); pn = (wgid % nig) / gsz;
        } else {
            const int s = (int)(L - nwg); ok = s < nN * S; sp = s / nN; pn = s - sp * nN; pm = nMp; nt = ntk / S; k0 = sp * nt * BK;
        }
        u.pm = pm; u.pn = pn; u.k0 = k0; u.nt = nt; u.sp = sp; u.hf = 0; return ok;
    }
    __device__ __forceinline__ void a_ready(const Unit&) const {}
    __device__ __forceinline__ void done(const Unit&) const {}
};
typedef float cvt_f32x2_t __attribute__((ext_vector_type(2))); typedef __bf16 cvt_bf16x2_t __attribute__((ext_vector_type(2)));
__device__ __forceinline__ unsigned cvt_pk_bf16(float lo, float hi) { cvt_f32x2_t v = {lo, hi}; cvt_bf16x2_t b = __builtin_convertvector(v, cvt_bf16x2_t); return __builtin_bit_cast(unsigned, b); }

typedef float f32x2 __attribute__((ext_vector_type(2)));
typedef unsigned u32x2 __attribute__((ext_vector_type(2)));
__device__ __forceinline__ u32x2 pack4(f32x4 v) { u32x2 w; w.x = cvt_pk_bf16(v[0], v[1]); w.y = cvt_pk_bf16(v[2], v[3]); return w; }
__device__ __forceinline__ void rope4(f32x4& x1, f32x4& x2, const f32x4 c, const f32x4 s) { const f32x4 a = x1 * c - x2 * s, b = x2 * c + x1 * s; x1 = a; x2 = b; }
__device__ __forceinline__ f32x4 sigmoid4(f32x4 v) { f32x4 o;
#pragma unroll
    for (int e = 0; e < 4; ++e) o[e] = __builtin_amdgcn_rcpf(1.0f + __builtin_amdgcn_exp2f(-1.4426950408889634f * v[e]));
    return o; }

struct RowStage {
    PG8_LAS unsigned char* grp; unsigned roff0, roff1;
    __device__ __forceinline__ void init(PG8_LAS unsigned char* stg, int wr, int wc, int lane) {
        grp = stg + wr * 8192; const int rr0 = 4 * wc + (lane >> 5), c = lane & 31;
        roff0 = (unsigned)rr0 * 512u + ((unsigned)((c & 16) | ((c ^ rr0) & 15)) << 4); roff1 = (unsigned)(rr0 + 2) * 512u + ((unsigned)((c & 16) | ((c ^ (rr0 + 2)) & 15)) << 4);
    }
    static __device__ __forceinline__ unsigned woff(int fr, int ch8) { const int c16 = ch8 >> 1; return (unsigned)fr * 512u + ((unsigned)((c16 & 16) | ((c16 ^ fr) & 15)) << 4) + (unsigned)(ch8 & 1) * 8u; }
    __device__ __forceinline__ void step(bool first, const unsigned (&wo)[4], const u32x2 (&p)[4], bf16_t* o, size_t ldc) const {
        if (!first) __builtin_amdgcn_s_barrier();
#pragma unroll
        for (int k = 0; k < 4; ++k) *(PG8_LAS u32x2*)(grp + wo[k]) = p[k];
        asm volatile("s_waitcnt lgkmcnt(0)" ::: "memory"); __builtin_amdgcn_s_barrier();
        const u32x4 r0 = *(const PG8_LAS u32x4*)(grp + roff0), r1 = *(const PG8_LAS u32x4*)(grp + roff1);
        asm volatile("s_waitcnt lgkmcnt(0)" ::: "memory");
        *(u32x4*)o = r0; *(u32x4*)(o + 2 * ldc) = r1;
    }
};

template <int ACT> struct EpiBf16 {
    static constexpr bool PERM = true, AFTER_DRAIN = false, STAGED = true;
    bf16_t* O; int ldc; int split_cols; size_t split_stride;
    template <bool HU> __device__ __forceinline__ void run(const f32x4 (&acc)[2][2][4][2], const Unit& u, int wr, int wc, int fr, int fq) const {
        const int row0 = u.pm * BM + wr * 64 + fr; int colt = u.pn * BM; bf16_t* base = O;
        if (split_cols) { const int t = colt / split_cols; base += (size_t)t * split_stride; colt -= t * split_cols; }
        const int col0 = colt + wc * 32 + 8 * fq;
#pragma unroll
        for (int ai = 0; ai < 2; ++ai)
#pragma unroll
            for (int m = 0; m < 4; ++m) { bf16_t* rowp = base + (size_t)(row0 + ai * HALF + m * 16) * ldc + col0;
#pragma unroll
                for (int bj = 0; bj < 2; ++bj) { f32x4 v0 = acc[ai][bj][m][0], v1 = acc[ai][bj][m][1];
                    if (ACT == 2) {
#pragma unroll
                        for (int e = 0; e < 4; ++e) { const float a = __builtin_amdgcn_fmed3f(v0[e], 0.f, 3.0e38f), b = __builtin_amdgcn_fmed3f(v1[e], 0.f, 3.0e38f); v0[e] = a * a; v1[e] = b * b; } }
                    u32x4 w; w.x = cvt_pk_bf16(v0[0], v0[1]); w.y = cvt_pk_bf16(v0[2], v0[3]); w.z = cvt_pk_bf16(v1[0], v1[1]); w.w = cvt_pk_bf16(v1[2], v1[3]);
                    *(u32x4*)(rowp + bj * HALF) = w; } }
    }
    template <bool HU> __device__ __forceinline__ void staged(const f32x4 (&acc)[2][2][4][2], const Unit& u, int wr, int wc, int fr, int fq, PG8_LAS unsigned char* stg, int lane) const {
        int colt = u.pn * BM; bf16_t* base = O;
        if (split_cols) { const int t = colt / split_cols; base += (size_t)t * split_stride; colt -= t * split_cols; }
        PG8_LAS unsigned char* grp = stg + wr * 8192;
        const unsigned woff = (unsigned)fr * 512u + ((((unsigned)(4 * wc + fq)) ^ (unsigned)fr) << 4);
        const int rr0 = 4 * wc + (lane >> 5), c = lane & 31;
        const unsigned roff0 = (unsigned)rr0 * 512u + ((unsigned)((c & 16) | ((c ^ rr0) & 15)) << 4), roff1 = (unsigned)(rr0 + 2) * 512u + ((unsigned)((c & 16) | ((c ^ (rr0 + 2)) & 15)) << 4);
        bf16_t* gp = base + (size_t)(u.pm * BM + (HU && u.hf ? HALF : 0) + wr * 64 + rr0) * ldc + colt + c * 8;
#pragma unroll
        for (int ai = 0; ai < (HU ? 1 : 2); ++ai)
#pragma unroll
            for (int m = 0; m < 4; ++m) {
                u32x4 w[2];
#pragma unroll
                for (int bj = 0; bj < 2; ++bj) { f32x4 v0 = acc[ai][bj][m][0], v1 = acc[ai][bj][m][1];
                    if (ACT == 2) {
#pragma unroll
                        for (int e = 0; e < 4; ++e) { const float a = __builtin_amdgcn_fmed3f(v0[e], 0.f, 3.0e38f), b = __builtin_amdgcn_fmed3f(v1[e], 0.f, 3.0e38f); v0[e] = a * a; v1[e] = b * b; } }
                    w[bj].x = cvt_pk_bf16(v0[0], v0[1]); w[bj].y = cvt_pk_bf16(v0[2], v0[3]); w[bj].z = cvt_pk_bf16(v1[0], v1[1]); w[bj].w = cvt_pk_bf16(v1[2], v1[3]); }
                if (ai | m) __builtin_amdgcn_s_barrier();
                *(PG8_LAS u32x4*)(grp + woff) = w[0]; *(PG8_LAS u32x4*)(grp + woff + 256) = w[1];
                asm volatile("s_waitcnt lgkmcnt(0)" ::: "memory"); __builtin_amdgcn_s_barrier();
                const u32x4 r0 = *(const PG8_LAS u32x4*)(grp + roff0), r1 = *(const PG8_LAS u32x4*)(grp + roff1);
                asm volatile("s_waitcnt lgkmcnt(0)" ::: "memory");
                bf16_t* o = gp + (size_t)(ai * HALF + m * 16) * ldc;
                *(u32x4*)o = r0; *(u32x4*)(o + (size_t)2 * ldc) = r1;
            }
        __builtin_amdgcn_s_barrier();
    }
};

struct EpiIn {
    static constexpr bool PERM = false, AFTER_DRAIN = false, STAGED = true;
    float* qraw; float* ckvraw; bf16_t* qb; bf16_t* qi; bf16_t* sga; bf16_t* sgb;
    bf16_t* kall; bf16_t* vall; bf16_t* kiall; bf16_t* kropeall; float* wi; float* out;
    const float* cos_m; const float* sin_m; const float* cos_d; const float* sin_d;
    template <bool HU> __device__ __forceinline__ void run(const f32x4 (&acc)[2][2][4][2], const Unit& u, int wr, int wc, int fr, int fq) const {
        const int pn = u.pn; const bool samp = (u.pm == SEQ / BM); const int rb = u.pm * BM + (HU && u.hf ? HALF : 0);
#pragma unroll
        for (int ai = 0; ai < (HU ? 1 : 2); ++ai)
#pragma unroll
            for (int m = 0; m < 4; ++m) {
                const int r = rb + ai * HALF + wr * 64 + m * 16 + fr;
                const int ro = samp ? r - SEQ : r;
                const int kr = row_key(r), pos = row_pos(r);
                if (pn < 4) {
#pragma unroll
                    for (int bj = 0; bj < 2; ++bj)
#pragma unroll
                        for (int n = 0; n < 2; ++n) *(f32x4*)(qraw + (size_t)r * QLORA + pn * BM + bj * HALF + wc * 32 + n * 16 + 4 * fq) = acc[ai][bj][m][n];
                } else if (pn < 6) {
#pragma unroll
                    for (int bj = 0; bj < 2; ++bj)
#pragma unroll
                        for (int n = 0; n < 2; ++n) *(f32x4*)(ckvraw + (size_t)r * KVLORA + (pn - 4) * BM + bj * HALF + wc * 32 + n * 16 + 4 * fq) = acc[ai][bj][m][n];
                } else if (pn < 78) {
                    const int kind = pn < 22 ? 0 : pn < 26 ? 1 : pn < 30 ? 2 : pn < 46 ? 3 : pn < 62 ? 4 : 5;
                    const int t0 = kind == 0 ? 6 : kind == 1 ? 22 : kind == 2 ? 26 : kind == 3 ? 30 : kind == 4 ? 46 : 62;
                    const bool roped = (kind == 0 || kind == 1 || kind == 3);
                    f32x4 cs = {0.f, 0.f, 0.f, 0.f}, sn = cs;
                    if (roped && wc == 0) { cs = *(const f32x4*)(cos_d + pos * 16 + 4 * fq); sn = *(const f32x4*)(sin_d + pos * 16 + 4 * fq); }
#pragma unroll
                    for (int bj = 0; bj < 2; ++bj) {
                        f32x4 v0 = acc[ai][bj][m][0], v1 = acc[ai][bj][m][1];
                        if (roped && wc == 0) rope4(v0, v1, cs, sn);
                        const int c0 = (pn - t0) * BM + bj * HALF + wc * 32 + 4 * fq;
                        if (kind == 0) { *(u32x2*)(qb + (size_t)r * DM + c0) = pack4(v0 * C_DSA); *(u32x2*)(qb + (size_t)r * DM + c0 + 16) = pack4(v1 * C_DSA); }
                        else if (kind == 3) { *(u32x2*)(qi + (size_t)r * DM + c0) = pack4(v0); *(u32x2*)(qi + (size_t)r * DM + c0 + 16) = pack4(v1); }
                        else if (kind == 4) { *(u32x2*)(sga + (size_t)r * DM + c0) = pack4(sigmoid4(v0)); *(u32x2*)(sga + (size_t)r * DM + c0 + 16) = pack4(sigmoid4(v1)); }
                        else if (kind == 5) { *(u32x2*)(sgb + (size_t)r * DM + c0) = pack4(sigmoid4(v0)); *(u32x2*)(sgb + (size_t)r * DM + c0 + 16) = pack4(sigmoid4(v1)); }
                        else {
                            float* o = out + (kind == 1 ? (samp ? O_K_S : O_K_P) : (samp ? O_V_S : O_V_P)) + (size_t)ro * 1024 + c0;
                            *(f32x4*)o = v0; *(f32x4*)(o + 16) = v1;
                            bf16_t* kb = (kind == 1 ? kall : vall) + (size_t)kr * 1024 + c0;
                            *(u32x2*)kb = pack4(v0); *(u32x2*)(kb + 16) = pack4(v1);
                        }
                    }
                } else {
                    {
                        f32x4 v0 = acc[ai][0][m][0], v1 = acc[ai][0][m][1];
                        if (wc < 2) {
                            const f32x4 cs = *(const f32x4*)(cos_m + pos * 32 + 16 * wc + 4 * fq), sn = *(const f32x4*)(sin_m + pos * 32 + 16 * wc + 4 * fq);
                            rope4(v0, v1, cs, sn);
                            float* o = out + (samp ? O_KROPE_S : O_KROPE_P) + (size_t)ro * 64 + 16 * wc + 4 * fq;
                            *(f32x4*)o = v0; *(f32x4*)(o + 32) = v1;
                            bf16_t* kb = kropeall + (size_t)kr * 64 + 16 * wc + 4 * fq;
                            *(u32x2*)kb = pack4(v0); *(u32x2*)(kb + 32) = pack4(v1);
                        } else if (wc == 2) {
                            *(f32x4*)(wi + (size_t)r * 32 + 4 * fq) = v0 * IDX_W_SCALE; *(f32x4*)(wi + (size_t)r * 32 + 16 + 4 * fq) = v1 * IDX_W_SCALE;
                        }
                    }
                    {
                        f32x4 v0 = acc[ai][1][m][0], v1 = acc[ai][1][m][1];
                        if (wc == 0) { const f32x4 cs = *(const f32x4*)(cos_d + pos * 16 + 4 * fq), sn = *(const f32x4*)(sin_d + pos * 16 + 4 * fq); rope4(v0, v1, cs, sn); }
                        const int c0 = wc * 32 + 4 * fq;
                        float* o = out + (samp ? O_KI_S : O_KI_P) + (size_t)ro * 128 + c0;
                        *(f32x4*)o = v0; *(f32x4*)(o + 16) = v1;
                        bf16_t* kb = kiall + (size_t)kr * 128 + c0;
                        *(u32x2*)kb = pack4(v0); *(u32x2*)(kb + 16) = pack4(v1);
                    }
                }
            }
    }
    template <bool HU> __device__ __forceinline__ void staged(const f32x4 (&acc)[2][2][4][2], const Unit& u, int wr, int wc, int fr, int fq, PG8_LAS unsigned char* stg, int lane) const {
        const int pn = u.pn;
        const int kind = pn < 22 ? 0 : pn < 26 ? 1 : pn < 30 ? 2 : pn < 46 ? 3 : pn < 62 ? 4 : 5;
        if (pn < 6 || pn >= 78 || kind == 1 || kind == 2) { this->template run<HU>(acc, u, wr, wc, fr, fq); return; }
        const int t0 = kind == 0 ? 6 : kind == 3 ? 30 : kind == 4 ? 46 : 62;
        const bool roped = (kind == 0 || kind == 3);
        bf16_t* const d0 = qb; bf16_t* const d3 = qi; bf16_t* const d4 = sga; bf16_t* const d5 = sgb;
        bf16_t* dst = kind == 0 ? d0 : kind == 3 ? d3 : kind == 4 ? d4 : d5;
        RowStage R; R.init(stg, wr, wc, lane);
        unsigned wo[4];
#pragma unroll
        for (int k = 0; k < 4; ++k) wo[k] = RowStage::woff(fr, 32 * (k >> 1) + 8 * wc + 4 * (k & 1) + fq);
        const int rb = u.pm * BM + (HU && u.hf ? HALF : 0);
        bf16_t* gp = dst + (size_t)(rb + wr * 64 + 4 * wc + (lane >> 5)) * DM + (pn - t0) * BM + (lane & 31) * 8;
#pragma unroll
        for (int ai = 0; ai < (HU ? 1 : 2); ++ai)
#pragma unroll
            for (int m = 0; m < 4; ++m) {
                const int r = rb + ai * HALF + wr * 64 + m * 16 + fr, pos = row_pos(r);
                f32x4 cs = {0.f, 0.f, 0.f, 0.f}, sn = cs;
                if (roped && wc == 0) { cs = *(const f32x4*)(cos_d + pos * 16 + 4 * fq); sn = *(const f32x4*)(sin_d + pos * 16 + 4 * fq); }
                u32x2 p[4];
#pragma unroll
                for (int bj = 0; bj < 2; ++bj) {
                    f32x4 v0 = acc[ai][bj][m][0], v1 = acc[ai][bj][m][1];
                    if (roped && wc == 0) rope4(v0, v1, cs, sn);
                    if (kind == 0) { p[2 * bj] = pack4(v0 * C_DSA); p[2 * bj + 1] = pack4(v1 * C_DSA); }
                    else if (kind == 3) { p[2 * bj] = pack4(v0); p[2 * bj + 1] = pack4(v1); }
                    else { p[2 * bj] = pack4(sigmoid4(v0)); p[2 * bj + 1] = pack4(sigmoid4(v1)); }
                }
                R.step((ai | m) == 0, wo, p, gp + (size_t)(ai * HALF + m * 16) * DM, DM);
            }
        __builtin_amdgcn_s_barrier();
    }
};

struct EpiUq {
    static constexpr bool PERM = false, AFTER_DRAIN = false, STAGED = true;
    bf16_t* qan; bf16_t* qar; const float* cos_m; const float* sin_m;
    template <bool HU> __device__ __forceinline__ void run(const f32x4 (&acc)[2][2][4][2], const Unit& u, int wr, int wc, int fr, int fq) const {
        const int pn = u.pn;
#pragma unroll
        for (int ai = 0; ai < 2; ++ai)
#pragma unroll
            for (int m = 0; m < 4; ++m) {
                const int r = u.pm * BM + ai * HALF + wr * 64 + m * 16 + fr;
                if (pn < 16) {
#pragma unroll
                    for (int bj = 0; bj < 2; ++bj)
#pragma unroll
                        for (int n = 0; n < 2; ++n) *(u32x2*)(qan + (size_t)r * 4096 + pn * BM + bj * HALF + wc * 32 + n * 16 + 4 * fq) = pack4(acc[ai][bj][m][n] * C_MLA);
                } else {
                    const int pos = row_pos(r), w = wc & 1;
                    const f32x4 cs = *(const f32x4*)(cos_m + pos * 32 + 16 * w + 4 * fq), sn = *(const f32x4*)(sin_m + pos * 32 + 16 * w + 4 * fq);
#pragma unroll
                    for (int bj = 0; bj < 2; ++bj) {
                        const int head = ((pn - 16) * 2 + bj) * 2 + (wc >> 1);
                        f32x4 v0 = acc[ai][bj][m][0], v1 = acc[ai][bj][m][1];
                        rope4(v0, v1, cs, sn);
                        bf16_t* o = qar + (size_t)r * 2048 + head * 64 + 16 * w + 4 * fq;
                        *(u32x2*)o = pack4(v0 * C_MLA); *(u32x2*)(o + 32) = pack4(v1 * C_MLA);
                    }
                }
            }
    }
    template <bool HU> __device__ __forceinline__ void staged(const f32x4 (&acc)[2][2][4][2], const Unit& u, int wr, int wc, int fr, int fq, PG8_LAS unsigned char* stg, int lane) const {
        const int pn = u.pn; const bool rp = pn >= 16; const int w = wc & 1;
        RowStage R; R.init(stg, wr, wc, lane);
        unsigned wo[4];
#pragma unroll
        for (int k = 0; k < 4; ++k) wo[k] = RowStage::woff(fr, rp ? 16 * (2 * (k >> 1) + (wc >> 1)) + 8 * (k & 1) + 4 * w + fq : 32 * (k >> 1) + 8 * wc + 4 * (k & 1) + fq);
        const size_t ldo = rp ? 2048 : 4096;
        bf16_t* const e0 = qar; bf16_t* const e1 = qan;
        bf16_t* gp = (rp ? e0 + (pn - 16) * BM : e1 + pn * BM) + (size_t)(u.pm * BM + wr * 64 + 4 * wc + (lane >> 5)) * ldo + (lane & 31) * 8;
#pragma unroll
        for (int ai = 0; ai < 2; ++ai)
#pragma unroll
            for (int m = 0; m < 4; ++m) {
                const int r = u.pm * BM + ai * HALF + wr * 64 + m * 16 + fr, pos = row_pos(r);
                f32x4 cs = {0.f, 0.f, 0.f, 0.f}, sn = cs;
                if (rp) { cs = *(const f32x4*)(cos_m + pos * 32 + 16 * w + 4 * fq); sn = *(const f32x4*)(sin_m + pos * 32 + 16 * w + 4 * fq); }
                u32x2 p[4];
#pragma unroll
                for (int bj = 0; bj < 2; ++bj) {
                    f32x4 v0 = acc[ai][bj][m][0], v1 = acc[ai][bj][m][1];
                    if (rp) rope4(v0, v1, cs, sn);
                    p[2 * bj] = pack4(v0 * C_MLA); p[2 * bj + 1] = pack4(v1 * C_MLA);
                }
                R.step((ai | m) == 0, wo, p, gp + (size_t)(ai * HALF + m * 16) * ldo, ldo);
            }
        __builtin_amdgcn_s_barrier();
    }
};

struct EpiRes {
    static constexpr bool PERM = false, AFTER_DRAIN = false, STAGED = false;
    const float* xp; const float* xs; float* y; const float* gate; float* slab;
    template <bool HU> __device__ __forceinline__ void run(const f32x4 (&acc)[2][2][4][2], const Unit& u, int wr, int wc, int fr, int fq) const {
        const int col0 = u.pn * BM + wc * 32 + 4 * fq;
        if (u.sp >= 0) {
#pragma unroll
            for (int ai = 0; ai < 2; ++ai)
#pragma unroll
                for (int m = 0; m < 4; ++m) { float* o = slab + ((size_t)u.sp * BM + ai * HALF + wr * 64 + m * 16 + fr) * DM + col0;
#pragma unroll
                    for (int bj = 0; bj < 2; ++bj)
#pragma unroll
                        for (int n = 0; n < 2; ++n) *(f32x4*)(o + bj * HALF + n * 16) = acc[ai][bj][m][n]; }
            return;
        }
#pragma unroll
        for (int ai = 0; ai < 2; ++ai)
#pragma unroll
            for (int m = 0; m < 4; ++m) {
                const int r = u.pm * BM + ai * HALF + wr * 64 + m * 16 + fr;
                const float* b = (r < SEQ ? xp + (size_t)r * DM : xs + (size_t)(r - SEQ) * DM) + col0;
                const float* g = gate + (size_t)row_vec(r) * NADA + col0;
                float* o = y + (size_t)r * DM + col0;
#pragma unroll
                for (int bj = 0; bj < 2; ++bj)
#pragma unroll
                    for (int n = 0; n < 2; ++n) { const int c = bj * HALF + n * 16; *(f32x4*)(o + c) = *(const f32x4*)(b + c) + *(const f32x4*)(g + c) * acc[ai][bj][m][n]; }
            }
    }
};
template <class Epi, class Sched, bool ALIGN_EPI = false, bool SP2 = false, bool HALFU = false>
__device__ __forceinline__ void gemm_phase(PG8_LAS unsigned char* lds, const Gemm g, const Sched& S, const Epi& E) {
    const int tid = threadIdx.x, wid = __builtin_amdgcn_readfirstlane(tid >> 6), lane = tid & 63, wr = wid >> 2, wc = wid & 3, fr = lane & 15, fq = lane >> 4;
    const int K = g.K, nt_full = K / BK;
    unsigned voffA[2], voffB[2];
#pragma unroll
    for (int i = 0; i < 2; ++i) { int R, C; stage_rc(tid * 16 + i * 8192, R, C); const int Rb = Epi::PERM ? ((R & ~31) + perm32(R & 31)) : R;
        voffA[i] = (unsigned)(R * K + C) * 2u; voffB[i] = (unsigned)(Rb * K + C) * 2u; }
    const size_t kstep = (size_t)(BK * 2);
    const size_t hstep = (size_t)HALF * K * 2;
    const size_t tstep = 2 * hstep;
    const unsigned ldsw = (unsigned)wid * 1024u;
    const int aoff = lds_byte(wr * 64 + fr, fq * 8), boff = lds_byte(wc * 32 + fr, fq * 8);
#define PG8_SA(b, h) (((b) * 2 + (h)) * HTB)
#define PG8_SB(b, h) ((4 + (b) * 2 + (h)) * HTB)
#define PG8_STAGE(bufoff, gbase, voff) do { _Pragma("unroll") for (int _i = 0; _i < 2; ++_i) \
        __builtin_amdgcn_global_load_lds((const unsigned*)((const char*)(gbase) + (voff)[_i]), (PG8_LAS unsigned*)(lds + (bufoff) + ldsw + _i * 8192), 16, 0, 0); } while (0)
#define PG8_LDA(dst, b, h) do { _Pragma("unroll") for (int m = 0; m < 4; ++m) _Pragma("unroll") for (int k = 0; k < 2; ++k) dst[m][k] = *(const PG8_LAS bf16x8*)(lds + PG8_SA(b, h) + aoff + m * 2048 + k * 1024); } while (0)
#define PG8_LDB(dst, b, h) do { _Pragma("unroll") for (int n = 0; n < 2; ++n) _Pragma("unroll") for (int k = 0; k < 2; ++k) dst[n][k] = *(const PG8_LAS bf16x8*)(lds + PG8_SB(b, h) + boff + n * 2048 + k * 1024); } while (0)
#define PG8_MMA(ai, bj, At, Bt) do { __builtin_amdgcn_s_setprio(1); _Pragma("unroll") for (int m = 0; m < 4; ++m) _Pragma("unroll") for (int n = 0; n < 2; ++n) _Pragma("unroll") for (int k = 0; k < 2; ++k) \
        acc[ai][bj][m][n] = __builtin_amdgcn_mfma_f32_16x16x32_bf16(Bt[n][k], At[m][k], acc[ai][bj][m][n], 0, 0, 0); __builtin_amdgcn_s_setprio(0); } while (0)
#define PG8_WAIT_V(n) asm volatile("s_waitcnt vmcnt(" #n ")" ::: "memory")
#define PG8_WAIT_L(n) asm volatile("s_waitcnt lgkmcnt(" #n ")" ::: "memory")
#define PG8_BAR __builtin_amdgcn_s_barrier()
#define PG8_SCHED __builtin_amdgcn_sched_barrier(0)
    Unit cur, nxt; int ui = 0;
    if (!S.next(0, cur)) return;
    f32x4 acc[2][2][4][2];
#pragma unroll
    for (int a = 0; a < 2; ++a)
#pragma unroll
        for (int b = 0; b < 2; ++b)
#pragma unroll
            for (int m = 0; m < 4; ++m)
#pragma unroll
                for (int n = 0; n < 2; ++n) acc[a][b][m][n] = (f32x4){0.f, 0.f, 0.f, 0.f};
    bf16x8 At[4][2], B0[2][2], B1[2][2];
    const char* cA = (const char*)g.A + (size_t)cur.pm * tstep + (HALFU && cur.hf ? hstep : (size_t)0) + (size_t)cur.k0 * 2; const char* cB = (const char*)g.Bt + (size_t)cur.pn * tstep + (size_t)cur.k0 * 2;
    S.a_ready(cur);
    if constexpr (SP2) {
        PG8_STAGE(PG8_SB(0, 0), cB, voffB); PG8_STAGE(PG8_SB(0, 1), cB + hstep, voffB); PG8_STAGE(PG8_SA(0, 0), cA, voffA); PG8_STAGE(PG8_SA(0, 1), cA + hstep, voffA);
        if (wr == 1) PG8_BAR;
        PG8_WAIT_V(2); PG8_BAR;
        PG8_STAGE(PG8_SB(1, 0), cB + kstep, voffB); PG8_STAGE(PG8_SA(1, 0), cA + kstep, voffA); PG8_STAGE(PG8_SB(1, 1), cB + hstep + kstep, voffB);
        PG8_WAIT_V(6); PG8_BAR;
    } else {
        PG8_STAGE(PG8_SB(0, 0), cB, voffB); PG8_STAGE(PG8_SA(0, 0), cA, voffA); PG8_STAGE(PG8_SB(0, 1), cB + hstep, voffB); PG8_STAGE(PG8_SA(0, 1), cA + hstep, voffA);
        if (wr == 1) PG8_BAR;
        PG8_WAIT_V(4); PG8_BAR;
        PG8_STAGE(PG8_SB(1, 0), cB + kstep, voffB); PG8_STAGE(PG8_SA(1, 0), cA + kstep, voffA); PG8_STAGE(PG8_SB(1, 1), cB + hstep + kstep, voffB);
        PG8_WAIT_V(6); PG8_BAR;
    }
    for (;;) {
        const bool has_next = S.next(ui + 1, nxt);
        const char* nA = has_next ? (const char*)g.A + (size_t)nxt.pm * tstep + (HALFU && nxt.hf ? hstep : (size_t)0) + (size_t)nxt.k0 * 2 : cA; const char* nB = has_next ? (const char*)g.Bt + (size_t)nxt.pn * tstep + (size_t)nxt.k0 * 2 : cB;
        const int nt = cur.nt ? cur.nt : nt_full;
        for (int t = 0; t < nt; t += 2) {
            const bool last = (t == nt - 2);
            const char* a1 = cA + (size_t)(t + 1) * kstep;
            const char* a2 = last ? nA : cA + (size_t)(t + 2) * kstep; const char* b2 = last ? nB : cB + (size_t)(t + 2) * kstep;
            const char* a3 = a2 + kstep; const char* b3 = b2 + kstep;
            if (last && has_next) S.a_ready(nxt);
            if constexpr (SP2) {
            PG8_LDB(B0, 0, 0); PG8_LDB(B1, 0, 1); PG8_SCHED; PG8_LDA(At, 0, 0); PG8_STAGE(PG8_SA(1, 1), a1 + hstep, voffA);
            PG8_WAIT_V(8); PG8_WAIT_L(0); PG8_BAR; PG8_MMA(0, 0, At, B0); PG8_MMA(0, 1, At, B1); PG8_BAR; PG8_SCHED;
            PG8_LDA(At, 0, 1); PG8_STAGE(PG8_SB(0, 0), b2, voffB); PG8_STAGE(PG8_SB(0, 1), b2 + hstep, voffB); PG8_STAGE(PG8_SA(0, 0), a2, voffA);
            PG8_WAIT_V(8); PG8_WAIT_L(0); PG8_BAR; if constexpr (!HALFU) { PG8_MMA(1, 0, At, B0); PG8_MMA(1, 1, At, B1); } PG8_BAR; PG8_SCHED;
            PG8_LDB(B0, 1, 0); PG8_LDB(B1, 1, 1); PG8_SCHED; PG8_LDA(At, 1, 0); PG8_STAGE(PG8_SA(0, 1), a2 + hstep, voffA);
            PG8_WAIT_V(8); PG8_WAIT_L(0); PG8_BAR; PG8_MMA(0, 0, At, B0); PG8_MMA(0, 1, At, B1); PG8_BAR; PG8_SCHED;
            PG8_LDA(At, 1, 1); PG8_STAGE(PG8_SB(1, 0), b3, voffB); PG8_STAGE(PG8_SB(1, 1), b3 + hstep, voffB); PG8_STAGE(PG8_SA(1, 0), a3, voffA);
            PG8_WAIT_V(8); PG8_WAIT_L(0); PG8_BAR; if constexpr (!HALFU) { PG8_MMA(1, 0, At, B0); PG8_MMA(1, 1, At, B1); } PG8_BAR; PG8_SCHED;
            } else {
            PG8_LDB(B0, 0, 0); PG8_SCHED; PG8_LDA(At, 0, 0); PG8_STAGE(PG8_SA(1, 1), a1 + hstep, voffA);
            PG8_WAIT_L(8); PG8_BAR; PG8_WAIT_L(0); PG8_MMA(0, 0, At, B0); PG8_BAR; PG8_SCHED;
            PG8_LDB(B1, 0, 1); PG8_STAGE(PG8_SB(0, 0), b2, voffB);
            PG8_BAR; PG8_WAIT_L(0); PG8_MMA(0, 1, At, B1); PG8_BAR;
            PG8_LDA(At, 0, 1); PG8_STAGE(PG8_SA(0, 0), a2, voffA);
            PG8_BAR; PG8_WAIT_L(0); PG8_MMA(1, 0, At, B0); PG8_BAR; PG8_SCHED;
            PG8_STAGE(PG8_SB(0, 1), b2 + hstep, voffB);
            PG8_WAIT_V(6); PG8_BAR; PG8_MMA(1, 1, At, B1); PG8_BAR;
            PG8_LDB(B0, 1, 0); PG8_SCHED; PG8_LDA(At, 1, 0); PG8_STAGE(PG8_SA(0, 1), a2 + hstep, voffA);
            PG8_WAIT_L(8); PG8_BAR; PG8_WAIT_L(0); PG8_MMA(0, 0, At, B0); PG8_BAR; PG8_SCHED;
            PG8_LDB(B1, 1, 1); PG8_STAGE(PG8_SB(1, 0), b3, voffB);
            PG8_BAR; PG8_WAIT_L(0); PG8_MMA(0, 1, At, B1); PG8_BAR;
            PG8_LDA(At, 1, 1); PG8_STAGE(PG8_SA(1, 0), a3, voffA);
            PG8_BAR; PG8_WAIT_L(0); PG8_MMA(1, 0, At, B0); PG8_BAR; PG8_SCHED;
            PG8_STAGE(PG8_SB(1, 1), b3 + hstep, voffB);
            PG8_WAIT_V(6); PG8_BAR; PG8_MMA(1, 1, At, B1); PG8_BAR;
            }
        }
        if constexpr (ALIGN_EPI) { if (wr == 0) PG8_BAR; }
        if constexpr (!Epi::AFTER_DRAIN) {
            if constexpr (Epi::STAGED) E.template staged<HALFU>(acc, cur, wr, wc, fr, fq, lds + PG8_SA(1, 1), lane);
            else E.template run<HALFU>(acc, cur, wr, wc, fr, fq);
            S.done(cur); }
        if (!has_next) break;
#pragma unroll
        for (int a = 0; a < 2; ++a)
#pragma unroll
            for (int b = 0; b < 2; ++b)
#pragma unroll
                for (int m = 0; m < 4; ++m)
#pragma unroll
                    for (int n = 0; n < 2; ++n) acc[a][b][m][n] = (f32x4){0.f, 0.f, 0.f, 0.f};
        cur = nxt; cA = nA; cB = nB; ++ui;
        if constexpr (ALIGN_EPI) { if (wr == 1) PG8_BAR; }
    }
    PG8_WAIT_V(0);
    if constexpr (!ALIGN_EPI) { if (wr == 0) PG8_BAR; }
    PG8_BAR;
    if constexpr (Epi::AFTER_DRAIN) { E.fused(acc, cur, wr, wc, fr, fq, lds, wid, lane); S.done(cur); }
#undef PG8_SA
#undef PG8_SB
#undef PG8_STAGE
#undef PG8_LDA
#undef PG8_LDB
#undef PG8_MMA
#undef PG8_WAIT_V
#undef PG8_WAIT_L
#undef PG8_BAR
#undef PG8_SCHED
}
}
#define XB_TMO      128
#define XB_XCNT(j)  (256  + 64 * (j))
#define XB_XSUB(j)  (1280 + 64 * (j))
#define XB_XGEN(j)  (2304 + 64 * (j))
#define XB_TOP      3328
#define XB_TOPGEN   3392
#define XCD_BAR_WORDS 3456
#define XB_SPIN_CAP (1u << 18)

__device__ __forceinline__ unsigned xb_ld(unsigned* p)              { return __hip_atomic_load(p, __ATOMIC_RELAXED, __HIP_MEMORY_SCOPE_AGENT); }
__device__ __forceinline__ unsigned xb_add(unsigned* p, unsigned v) { return __hip_atomic_fetch_add(p, v, __ATOMIC_RELAXED, __HIP_MEMORY_SCOPE_AGENT); }
__device__ __forceinline__ unsigned xb_xcc_id() { return (unsigned)__builtin_amdgcn_s_getreg((3 << 11) | 20) & 0xFu; }
#define XB_SPIN(cond, bar) do { unsigned _sp = 0; while (cond) { __builtin_amdgcn_s_sleep(1); \
    if ((++_sp & 255u) == 0u) { if (xb_ld(&(bar)[XB_TMO])) break; if (_sp > XB_SPIN_CAP) { atomicAdd(&(bar)[XB_TMO], 1u); break; } } } } while (0)

struct XcdBarrier {
    unsigned* bar; unsigned x;
    volatile LAS unsigned* st;
};

__device__ __forceinline__ XcdBarrier xcd_barrier_post(unsigned* bar, volatile LAS unsigned* st) {
    XcdBarrier b; b.bar = bar; b.x = xb_xcc_id(); b.st = st;
    if (threadIdx.x == 0) (void)xb_add(&bar[XB_XCNT(b.x)], 1u);
    return b;
}
__device__ __forceinline__ void xcd_barrier_complete(unsigned* bar, unsigned x, unsigned& nloc, unsigned& nx) {
    const unsigned G = gridDim.x * gridDim.y * gridDim.z;
    unsigned sum, cnt, mine, sp = 0u;
    for (;;) {
        sum = 0u; cnt = 0u; mine = 0u;
#pragma unroll
        for (unsigned j = 0; j < 16; ++j) { const unsigned c = xb_ld(&bar[XB_XCNT(j)]); sum += c; cnt += (c > 0u) ? 1u : 0u; mine = (j == x) ? c : mine; }
        if (sum == G) break;
        __builtin_amdgcn_s_sleep(1);
        if ((++sp & 255u) == 0u) { if (xb_ld(&bar[XB_TMO])) break; if (sp > XB_SPIN_CAP) { atomicAdd(&bar[XB_TMO], 1u); break; } }
    }
    nloc = mine > 0u ? mine : 1u; nx = cnt > 0u ? cnt : 1u;
}

__device__ __forceinline__ void xcd_barrier(const XcdBarrier& b) {
    asm volatile("s_waitcnt vmcnt(0)" ::: "memory");
    __syncthreads();
    if (threadIdx.x == 0) {
        unsigned* bar = b.bar;
        __builtin_amdgcn_s_waitcnt(0);
        unsigned nloc = b.st[0], nx = b.st[1];
        if (nloc == 0u) { xcd_barrier_complete(bar, b.x, nloc, nx); b.st[0] = nloc; b.st[1] = nx; }
        const unsigned old = xb_add(&bar[XB_XSUB(b.x)], 1u);
        const unsigned gen = old / nloc;
        if (old + 1u == (gen + 1u) * nloc) {
            __builtin_amdgcn_fence(__ATOMIC_RELEASE, "agent");
            asm volatile("s_waitcnt vmcnt(0)" ::: "memory");
            const unsigned og = xb_add(&bar[XB_TOP], 1u);
            const unsigned tg = og / nx;
            if (og + 1u == (tg + 1u) * nx) xb_add(&bar[XB_TOPGEN], 1u);
            else XB_SPIN(xb_ld(&bar[XB_TOPGEN]) == tg, bar);
            __builtin_amdgcn_fence(__ATOMIC_ACQUIRE, "agent");
            xb_add(&bar[XB_XGEN(b.x)], 1u);
            asm volatile("s_waitcnt vmcnt(0)" ::: "memory");
        } else {
            XB_SPIN(xb_ld(&bar[XB_XGEN(b.x)]) == gen, bar);
            __builtin_amdgcn_fence(__ATOMIC_ACQUIRE, "agent");
            asm volatile("s_waitcnt vmcnt(0)" ::: "memory");
        }
    }
    __syncthreads();
}

constexpr int NWAVES = 8;
struct Args { const float* in[N_IN]; float* out; unsigned char* ws; int ph_lo, ph_hi, li, pad; };
struct Ctx {
    LAS unsigned char* lds; const Args* a; unsigned char* ws; float* out;
    int tid, lane, wave, G, bx;
};
__device__ __forceinline__ float silu(float x) { return x / (1.0f + __expf(-x)); }

constexpr int ADA_NSPLIT = 21, ADA_NCG = NADA / 4 / 512;
constexpr int ADA_WCG = NADA / 4 / 64;
__device__ __forceinline__ void p0_wave_item(const Ctx& C, int item) {
    if (item >= ADA_WCG * ADA_NSPLIT) return;
    LAS float* sv = (LAS float*)(C.lds + C.wave * 16384);
    const float* cp = C.a->in[I_CP]; const float* cs = C.a->in[I_CS]; const float* W = C.a->in[I_WADA]; const float* B = C.a->in[I_BADA];
    float* ada = (float*)(C.ws + WS_ADA); const int lane = C.lane;
    const int cg = item % ADA_WCG, sp = item / ADA_WCG;
    const int d0 = sp * DM / ADA_NSPLIT, d1 = (sp + 1) * DM / ADA_NSPLIT, dn = d1 - d0;
    LDS_WAIT(); asm volatile("" ::: "memory");
    for (int i = lane; i < dn * NVEC; i += 64) { const int d = i / NVEC, v = i % NVEC; const float x = v == 0 ? cp[d0 + d] : cs[(size_t)(v - 1) * DM + d0 + d]; sv[d * 20 + v] = silu(x); }
    LDS_WAIT(); asm volatile("" ::: "memory");
    const int e0 = (cg * 64 + lane) * 4;
    v4f acc[NVEC];
#pragma unroll
    for (int v = 0; v < NVEC; ++v) acc[v] = (v4f){0.f, 0.f, 0.f, 0.f};
    const float* wp = W + (size_t)d0 * NADA + e0;
    int d = 0;
    for (; d + 4 <= dn; d += 4) {
        v4f w[4];
#pragma unroll
        for (int k = 0; k < 4; ++k) w[k] = __builtin_nontemporal_load((const v4f*)(wp + (size_t)(d + k) * NADA));
#pragma unroll
        for (int k = 0; k < 4; ++k) {
            const LAS v4f* s4 = (const LAS v4f*)(sv + (d + k) * 20);
            const v4f s0 = s4[0], s1 = s4[1], s2 = s4[2], s3 = s4[3]; const float s16 = sv[(d + k) * 20 + 16];
#pragma unroll
            for (int v = 0; v < 4; ++v) { acc[v] += s0[v] * w[k]; acc[4 + v] += s1[v] * w[k]; acc[8 + v] += s2[v] * w[k]; acc[12 + v] += s3[v] * w[k]; }
            acc[16] += s16 * w[k];
        }
    }
    for (; d < dn; ++d) { const v4f w = *(const v4f*)(wp + (size_t)d * NADA);
#pragma unroll
        for (int v = 0; v < NVEC; ++v) acc[v] += sv[d * 20 + v] * w; }
    if (sp == 0) { const v4f b = *(const v4f*)(B + e0);
#pragma unroll
        for (int v = 0; v < NVEC; ++v) acc[v] += b; }
#pragma unroll
    for (int v = 0; v < NVEC; ++v)
#pragma unroll
        for (int e = 0; e < 4; ++e) atomicAdd(ada + (size_t)v * NADA + e0 + e, acc[v][e]);
    LDS_WAIT(); asm volatile("" ::: "memory");
}

__device__ __forceinline__ int kperm64(int d) { return 32 * ((d >> 4) & 1) + 16 * (d >> 5) + (d & 15); }
__device__ __forceinline__ int win_dst(int n) {
    if (n < 1536) return n;
    if (n < 1600) return 78 * 256 + kperm64(n - 1536);
    if (n < 5696) return 6 * 256 + (n - 1600);
    if (n < 6720) return 22 * 256 + (n - 5696);
    if (n < 7744) return 26 * 256 + (n - 6720);
    if (n < 11840) return 30 * 256 + (n - 7744);
    if (n < 11968) return 78 * 256 + 128 + (n - 11840);
    if (n < 12000) return 78 * 256 + 64 + (n - 11968);
    if (n < 16096) return 46 * 256 + (n - 12000);
    return 62 * 256 + (n - 16096);
}
__device__ __forceinline__ int wuq_dst(int n) { const int h = n / 192, dd = n % 192; return dd < 128 ? h * 128 + dd : 4096 + (h >> 1) * 128 + (h & 1) * 64 + kperm64(dd - 128); }
template <int MAP> __device__ __forceinline__ void transpose_item(const float* W, int K, int N, bf16* WT, int row_off, LAS float* scr, int item, int lane) {
    const int nblk = N / 32, kb = item / nblk, nb = item % nblk, k0 = 64 * kb, n0 = 32 * nb;
#pragma unroll 8
    for (int i = 0; i < 32; ++i) { const int kk = 2 * i + (lane >> 5); scr[kk * 33 + (lane & 31)] = __builtin_nontemporal_load(W + (size_t)(k0 + kk) * N + n0 + (lane & 31)); }
    LDS_WAIT(); asm volatile("" ::: "memory");
    const int c = lane & 7;
#pragma unroll
    for (int j = 0; j < 4; ++j) { const int n = (lane >> 3) + 8 * j; const LAS float* s = scr + (8 * c) * 33 + n;
        v4u o; o.x = pk2(s[0 * 33], s[1 * 33]); o.y = pk2(s[2 * 33], s[3 * 33]); o.z = pk2(s[4 * 33], s[5 * 33]); o.w = pk2(s[6 * 33], s[7 * 33]);
        const int dr = MAP == 1 ? win_dst(n0 + n) : MAP == 2 ? wuq_dst(n0 + n) : n0 + n;
        *(GAS v4u*)(WT + (size_t)(row_off + dr) * K + k0 + 8 * c) = o; }
    LDS_WAIT(); asm volatile("" ::: "memory");
}
__device__ __forceinline__ void cvt_row(const float* src, bf16* dst, int n, int lane) {
    for (int i = lane * 8; i < n; i += 512) { const v4f a = *(const v4f*)(src + i), b = *(const v4f*)(src + i + 4);
        v4u o; o.x = pk2(a[0], a[1]); o.y = pk2(a[2], a[3]); o.z = pk2(b[0], b[1]); o.w = pk2(b[2], b[3]); *(v4u*)(dst + i) = o; }
}
__device__ __forceinline__ void zero_row(bf16* dst, int n, int lane) { for (int i = lane * 8; i < n; i += 512) *(v4u*)(dst + i) = (v4u){0u, 0u, 0u, 0u}; }
__device__ __forceinline__ void sincos_acc(float a, float& c, float& s) {
    const double x = (double)a; const double q = __builtin_rint(x * 0.63661977236758134308);
    const double t = (x - q * 1.5707963267948965580) - q * 6.1232339957367658860e-17, t2 = t * t;
    double sp = 1.0 / 6227020800.0; sp = sp * t2 - 1.0 / 39916800.0; sp = sp * t2 + 1.0 / 362880.0; sp = sp * t2 - 1.0 / 5040.0; sp = sp * t2 + 1.0 / 120.0; sp = sp * t2 - 1.0 / 6.0; sp = sp * t2 + 1.0;
    const double sn = sp * t;
    double cp = -1.0 / 87178291200.0; cp = cp * t2 + 1.0 / 479001600.0; cp = cp * t2 - 1.0 / 3628800.0; cp = cp * t2 + 1.0 / 40320.0; cp = cp * t2 - 1.0 / 720.0; cp = cp * t2 + 1.0 / 24.0; cp = cp * t2 - 0.5; cp = cp * t2 + 1.0;
    const int k = (int)((long long)q & 3);
    const double cc = (k == 0) ? cp : (k == 1) ? -sn : (k == 2) ? -cp : sn;
    const double ss = (k == 0) ? sn : (k == 1) ? cp : (k == 2) ? -sn : -cp;
    c = (float)cc; s = (float)ss;
}
__device__ __forceinline__ float pow_int(double base, int j) { double r = 1.0; for (int i = 0; i < j; ++i) r *= base; return (float)r; }
__device__ __forceinline__ void modnorm_row(const float* xrow, const float* g, const float* sc, const float* sh, bf16* orow, int lane) {
    v4f v[16]; float s = 0.f;
#pragma unroll
    for (int j = 0; j < 16; ++j) { v[j] = *(const v4f*)(xrow + 4 * lane + 256 * j); s += (v[j][0] * v[j][0] + v[j][1] * v[j][1]) + (v[j][2] * v[j][2] + v[j][3] * v[j][3]); }
    const float rstd = 1.0f / sqrtf(wave_sum(s) * (1.0f / DM) + EPS);
#pragma unroll
    for (int j = 0; j < 16; ++j) { const int c = 4 * lane + 256 * j; const v4f gg = *(const v4f*)(g + c), a = *(const v4f*)(sc + c), b = *(const v4f*)(sh + c);
        const v4f y = (v[j] * rstd) * gg * (a + 1.0f) + b; v2u o; o.x = pk2(y[0], y[1]); o.y = pk2(y[2], y[3]); *(v2u*)(orow + c) = o; }
}
__device__ __forceinline__ void p01_gemv_and_copies(const Ctx& C) {
    if (C.wave < 4) for (int it = C.bx * 4 + C.wave; it < ADA_WCG * ADA_NSPLIT; it += 8 * C.G) p0_wave_item(C, it);
    LAS float* scr = (LAS float*)(C.lds + C.wave * 16384);
    const int gw = C.bx * NWAVES + C.wave, NGW = C.G * NWAVES, lane = C.lane;
    const Args& A = *C.a; unsigned char* ws = C.ws;
    constexpr int I_IN = (DM / 64) * (DIN / 32), I_UQ = (QLORA / 64) * (6144 / 32), I_UK = (KVLORA / 64) * (4096 / 32), I_OUT = (DM / 64) * (DM / 32), I_UP = (DM / 64) * (DFF / 32), I_DN = (DFF / 64) * (DM / 32);
    constexpr int NITEMS = I_IN + I_UQ + 2 * I_UK + I_OUT + I_UP + I_DN;
    for (int it = gw; it < NITEMS; it += NGW) {
        int r = it;
        if (r < I_IN) { transpose_item<1>(A.in[I_WIN], DM, DIN, (bf16*)(ws + WS_WIN), 0, scr, r, lane); continue; } r -= I_IN;
        if (r < I_UQ) { transpose_item<2>(A.in[I_WUQ], QLORA, 6144, (bf16*)(ws + WS_WUQ), 0, scr, r, lane); continue; } r -= I_UQ;
        if (r < I_UK) { transpose_item<0>(A.in[I_WUK], KVLORA, 4096, (bf16*)(ws + WS_WUKV), 0, scr, r, lane); continue; } r -= I_UK;
        if (r < I_UK) { transpose_item<0>(A.in[I_WUV], KVLORA, 4096, (bf16*)(ws + WS_WUKV), 4096, scr, r, lane); continue; } r -= I_UK;
        if (r < I_OUT) { transpose_item<0>(A.in[I_WOUT], DM, DM, (bf16*)(ws + WS_WOUT), 0, scr, r, lane); continue; } r -= I_OUT;
        if (r < I_UP) { transpose_item<0>(A.in[I_WUP], DM, DFF, (bf16*)(ws + WS_WUP), 0, scr, r, lane); continue; } r -= I_UP;
        transpose_item<0>(A.in[I_WDOWN], DFF, DM, (bf16*)(ws + WS_WDOWN), 0, scr, r, lane);
    }
    for (int i = gw; i < 32; i += NGW) zero_row((bf16*)(ws + WS_WIN) + (size_t)(78 * 256 + 96 + i) * DM, DM, lane);
    for (int i = gw; i < DEC_B * SPITCH; i += NGW) {
        const int b = i / SPITCH, l = i % SPITCH; const size_t kr = (size_t)SEQ + i, cr = (size_t)b * PAST + l;
        bf16* ck = (bf16*)(ws + WS_CKV) + kr * 512; bf16* kp = (bf16*)(ws + WS_KROPE) + kr * 64; bf16* ka = (bf16*)(ws + WS_KALL) + kr * 1024; bf16* va = (bf16*)(ws + WS_VALL) + kr * 1024; bf16* ki = (bf16*)(ws + WS_KI) + kr * 128;
        if (l < PAST) { cvt_row(A.in[I_CCKV] + cr * 512, ck, 512, lane); cvt_row(A.in[I_CKROPE] + cr * 64, kp, 64, lane); cvt_row(A.in[I_CK] + cr * 1024, ka, 1024, lane);
                        cvt_row(A.in[I_CV] + cr * 1024, va, 1024, lane); cvt_row(A.in[I_CKI] + cr * 128, ki, 128, lane); }
        else if (l >= SKEYS) { zero_row(ck, 512, lane); zero_row(kp, 64, lane); zero_row(ka, 1024, lane); zero_row(va, 1024, lane); zero_row(ki, 128, lane); }
    }
    {
        float* cm = (float*)(ws + WS_ROPE); float* sm = cm + SEQ * 32; float* cd = sm + SEQ * 32; float* sd = cd + SEQ * 16;
        for (int i = gw * 64 + lane; i < SEQ * 48; i += NGW * 64) {
            const int pos = i / 48, j = i % 48; float c, s;
            if (j < 32) { const float inv = pow_int(0.74989420933245582730, j); sincos_acc((float)pos * inv, c, s); cm[pos * 32 + j] = c; sm[pos * 32 + j] = s; }
            else { const int k = j - 32; const float inv = pow_int(0.44036660267178047359, k); sincos_acc((float)pos * inv, c, s); cd[pos * 16 + k] = c; sd[pos * 16 + k] = s; }
        }
    }
    if (C.wave >= 4) for (int it = (C.G + C.bx) * 4 + (C.wave - 4); it < ADA_WCG * ADA_NSPLIT; it += 8 * C.G) p0_wave_item(C, it);
}
__device__ __forceinline__ void p1_modnorm(const Ctx& C) {
    const int gw = C.bx * NWAVES + C.wave, NGW = C.G * NWAVES, lane = C.lane;
    const Args& A = *C.a; unsigned char* ws = C.ws;
    {
        const float* ada = (const float*)(ws + WS_ADA);
        for (int r = gw; r < NROW; r += NGW) {
            const float* xr = r < SEQ ? A.in[I_XP] + (size_t)r * DM : A.in[I_XS] + (size_t)(r - SEQ) * DM; const float* av = ada + (size_t)row_vec(r) * NADA;
            modnorm_row(xr, A.in[I_G1], av + 1 * DM, av + 0 * DM, (bf16*)(ws + WS_XN) + (size_t)r * DM, lane);
        }
    }
}
__device__ __forceinline__ void p3_norms(const Ctx& C) {
    const int gw = C.bx * NWAVES + C.wave, NGW = C.G * NWAVES, lane = C.lane; const Args& A = *C.a; unsigned char* ws = C.ws;
    const float* gq = A.in[I_GQ]; const float* gkv = A.in[I_GKV];
    for (int r = gw; r < NROW; r += NGW) {
        {
            const float* x = (const float*)(ws + WS_QRAW) + (size_t)r * QLORA; v4f v[4]; float s = 0.f;
#pragma unroll
            for (int j = 0; j < 4; ++j) { v[j] = *(const v4f*)(x + 4 * lane + 256 * j); s += (v[j][0] * v[j][0] + v[j][1] * v[j][1]) + (v[j][2] * v[j][2] + v[j][3] * v[j][3]); }
            const float rstd = 1.0f / sqrtf(wave_sum(s) * (1.0f / QLORA) + EPS); bf16* o = (bf16*)(ws + WS_QN) + (size_t)r * QLORA;
#pragma unroll
            for (int j = 0; j < 4; ++j) { const int c = 4 * lane + 256 * j; const v4f y = (v[j] * rstd) * *(const v4f*)(gq + c); v2u w; w.x = pk2(y[0], y[1]); w.y = pk2(y[2], y[3]); *(v2u*)(o + c) = w; }
        }
        {
            const float* x = (const float*)(ws + WS_CKVRAW) + (size_t)r * KVLORA; v4f v[2]; float s = 0.f;
#pragma unroll
            for (int j = 0; j < 2; ++j) { v[j] = *(const v4f*)(x + 4 * lane + 256 * j); s += (v[j][0] * v[j][0] + v[j][1] * v[j][1]) + (v[j][2] * v[j][2] + v[j][3] * v[j][3]); }
            const float rstd = 1.0f / sqrtf(wave_sum(s) * (1.0f / KVLORA) + EPS);
            float* of = C.out + (r < SEQ ? O_CKV_P + (size_t)r * KVLORA : O_CKV_S + (size_t)(r - SEQ) * KVLORA); bf16* ob = (bf16*)(ws + WS_CKV) + (size_t)row_key(r) * KVLORA;
#pragma unroll
            for (int j = 0; j < 2; ++j) { const int c = 4 * lane + 256 * j; const v4f y = (v[j] * rstd) * *(const v4f*)(gkv + c); *(v4f*)(of + c) = y; v2u w; w.x = pk2(y[0], y[1]); w.y = pk2(y[2], y[3]); *(v2u*)(ob + c) = w; }
        }
    }
}
template <int S> __device__ __forceinline__ void sample_row_sum(const Ctx& C, int i, const float* base, const float* gate, v4f (&v)[2], float& rstd) {
    const float* slab = (const float*)(C.ws + WS_SLAB); LAS float* red = (LAS float*)C.lds; float ss = 0.f;
#pragma unroll
    for (int j = 0; j < 2; ++j) { const int c = 512 * C.wave + 4 * C.lane + 256 * j; v4f a = {0.f, 0.f, 0.f, 0.f};
#pragma unroll
        for (int s = 0; s < S; ++s) a += *(const v4f*)(slab + ((size_t)s * 256 + i) * DM + c);
        v[j] = *(const v4f*)(base + c) + *(const v4f*)(gate + c) * a; ss += (v[j][0] * v[j][0] + v[j][1] * v[j][1]) + (v[j][2] * v[j][2] + v[j][3] * v[j][3]); }
    ss = wave_sum(ss); __syncthreads(); if (C.lane == 0) red[C.wave] = ss; __syncthreads();
    float t = 0.f;
#pragma unroll
    for (int w = 0; w < 8; ++w) t += red[w];
    rstd = 1.0f / sqrtf(t * (1.0f / DM) + EPS);
}
__device__ __forceinline__ void p9_h2(const Ctx& C) {
    const int gw = C.bx * NWAVES + C.wave, NGW = C.G * NWAVES; const Args& A = *C.a; const float* ada = (const float*)(C.ws + WS_ADA);
    for (int i = C.bx; i < NSAMP; i += C.G) {
        const int r = SEQ + i; const float* av = ada + (size_t)row_vec(r) * NADA; v4f v[2]; float rstd;
        sample_row_sum<SPLIT_OUT>(C, i, A.in[I_XS] + (size_t)i * DM, av + 2 * DM, v, rstd);
#pragma unroll
        for (int j = 0; j < 2; ++j) { const int c = 512 * C.wave + 4 * C.lane + 256 * j; *(v4f*)(C.out + O_Y + (size_t)r * DM + c) = v[j];
            const v4f y = (v[j] * rstd) * *(const v4f*)(A.in[I_G2] + c) * (*(const v4f*)(av + 4 * DM + c) + 1.0f) + *(const v4f*)(av + 3 * DM + c);
            v2u o; o.x = pk2(y[0], y[1]); o.y = pk2(y[2], y[3]); *(v2u*)((bf16*)(C.ws + WS_XN) + (size_t)r * DM + c) = o; }
    }
    for (int r = gw; r < SEQ; r += NGW) { const float* av = ada + (size_t)row_vec(r) * NADA;
        modnorm_row(C.out + O_Y + (size_t)r * DM, A.in[I_G2], av + 4 * DM, av + 3 * DM, (bf16*)(C.ws + WS_XN) + (size_t)r * DM, C.lane); }
}
__device__ __forceinline__ void p12_final(const Ctx& C) {
    const int gw = C.bx * NWAVES + C.wave, NGW = C.G * NWAVES, lane = C.lane; const float* g = C.a->in[I_GF]; const float* ada = (const float*)(C.ws + WS_ADA);
    for (int i = C.bx; i < NSAMP; i += C.G) {
        const int r = SEQ + i; const float* av = ada + (size_t)row_vec(r) * NADA; v4f v[2]; float rstd; float* y = C.out + O_Y + (size_t)r * DM;
        sample_row_sum<SPLIT_DOWN>(C, i, y, av + 5 * DM, v, rstd);
#pragma unroll
        for (int j = 0; j < 2; ++j) { const int c = 512 * C.wave + 4 * C.lane + 256 * j; *(v4f*)(y + c) = (v[j] * rstd) * *(const v4f*)(g + c); }
    }
    for (int r = gw; r < SEQ; r += NGW) {
        float* x = C.out + O_Y + (size_t)r * DM; v4f v[16]; float s = 0.f;
#pragma unroll
        for (int j = 0; j < 16; ++j) { v[j] = *(const v4f*)(x + 4 * lane + 256 * j); s += (v[j][0] * v[j][0] + v[j][1] * v[j][1]) + (v[j][2] * v[j][2] + v[j][3] * v[j][3]); }
        const float rstd = 1.0f / sqrtf(wave_sum(s) * (1.0f / DM) + EPS);
#pragma unroll
        for (int j = 0; j < 16; ++j) { const int c = 4 * lane + 256 * j; *(v4f*)(x + c) = (v[j] * rstd) * *(const v4f*)(g + c); }
    }
}
namespace att {
typedef short bf16x8 __attribute__((ext_vector_type(8)));
typedef short s16x4 __attribute__((ext_vector_type(4)));
typedef float f32x16 __attribute__((ext_vector_type(16)));
typedef unsigned u32x4 __attribute__((ext_vector_type(4)));
typedef unsigned long long u64;
constexpr int L_KN = 0, L_V = 32768, L_KR = 81920, L_WS = 98304, L_END = 100352;
#define SBAR() __builtin_amdgcn_sched_barrier(0)
#define BAR() do { __builtin_amdgcn_s_barrier(); asm volatile("" ::: "memory"); } while (0)
__device__ __forceinline__ int crow(int r, int hi) { return (r & 3) + 8 * (r >> 2) + 4 * hi; }
__device__ __forceinline__ unsigned cvtpk(float lo, float hi) { return pg8::cvt_pk_bf16(lo, hi); }
__device__ __forceinline__ int swap23(int k) { return (k & ~0xC) | ((k & 4) << 1) | ((k & 8) >> 1); }
__device__ __forceinline__ void glds(const void* g, LAS unsigned char* l) { __builtin_amdgcn_global_load_lds((const unsigned*)g, (LAS unsigned*)l, 16, 0, 0); }
template <int OFF> __device__ __forceinline__ s16x4 tr_read(unsigned vb) { s16x4 r; asm volatile("ds_read_b64_tr_b16 %0, %1 offset:%2" : "=&v"(r) : "v"(vb), "i"(OFF) : "memory"); return r; }
constexpr int v_rd_off(int d0, int ks, int half) { return d0 * 512 + ks * 4096 + half * 2048; }
__device__ __forceinline__ unsigned v_rd_base(int lane) { return ((lane & 3) << 3) | (((lane >> 2) & 3) << 6) | (((lane >> 4) & 1) << 5) | (((lane >> 5) & 1) << 8); }
struct VFrag { s16x4 l0, h0, l1, h1, l2, h2, l3, h3; };
template <int D0> __device__ __forceinline__ void pv_read(VFrag& f, unsigned vb) {
    f.l0 = tr_read<v_rd_off(D0, 0, 0)>(vb); f.h0 = tr_read<v_rd_off(D0, 0, 1)>(vb); f.l1 = tr_read<v_rd_off(D0, 1, 0)>(vb); f.h1 = tr_read<v_rd_off(D0, 1, 1)>(vb);
    f.l2 = tr_read<v_rd_off(D0, 2, 0)>(vb); f.h2 = tr_read<v_rd_off(D0, 2, 1)>(vb); f.l3 = tr_read<v_rd_off(D0, 3, 0)>(vb); f.h3 = tr_read<v_rd_off(D0, 3, 1)>(vb);
}
__device__ __forceinline__ void pv_mma(f32x16& od, const VFrag& f, bf16x8 pa0, bf16x8 pa1, bf16x8 pa2, bf16x8 pa3) {
#define PK(L, H) (bf16x8){L[0], L[1], L[2], L[3], H[0], H[1], H[2], H[3]}
    od = __builtin_amdgcn_mfma_f32_32x32x16_bf16(pa0, PK(f.l0, f.h0), od, 0, 0, 0);
    od = __builtin_amdgcn_mfma_f32_32x32x16_bf16(pa1, PK(f.l1, f.h1), od, 0, 0, 0);
    od = __builtin_amdgcn_mfma_f32_32x32x16_bf16(pa2, PK(f.l2, f.h2), od, 0, 0, 0);
    od = __builtin_amdgcn_mfma_f32_32x32x16_bf16(pa3, PK(f.l3, f.h3), od, 0, 0, 0);
#undef PK
}
__device__ __forceinline__ void pv_all(f32x16 (&o)[4], unsigned vb, bf16x8 pa0, bf16x8 pa1, bf16x8 pa2, bf16x8 pa3) {
    VFrag fa, fb;
    pv_read<0>(fa, vb);
    pv_read<1>(fb, vb); asm volatile("s_waitcnt lgkmcnt(8)" ::: "memory"); SBAR(); pv_mma(o[0], fa, pa0, pa1, pa2, pa3); SBAR();
    pv_read<2>(fa, vb); asm volatile("s_waitcnt lgkmcnt(8)" ::: "memory"); SBAR(); pv_mma(o[1], fb, pa0, pa1, pa2, pa3); SBAR();
    pv_read<3>(fb, vb); asm volatile("s_waitcnt lgkmcnt(8)" ::: "memory"); SBAR(); pv_mma(o[2], fa, pa0, pa1, pa2, pa3); SBAR();
    asm volatile("s_waitcnt lgkmcnt(0)" ::: "memory"); SBAR(); pv_mma(o[3], fb, pa0, pa1, pa2, pa3);
}

struct Desc {
    const bf16* K; int ldk; const bf16* Kr; const bf16* V; int ldv; int NT, nvis;
    u64 lastmask;
    int tok0, tmask, hshift, hcol0, nvalid;
};
template <int KIND>
__device__ __forceinline__ void attn_unit(LAS unsigned char* lds, const Desc& D, const bf16* QN, const bf16* QR, const u64* MASK, const bf16* GATE, const bf16* ADDB, bf16* OUT, int wid, int lane) {
    constexpr int NQ = KIND == 0 ? 12 : 8;
    asm volatile("" : "+v"(lane));
    const int r32 = lane & 31, hi = lane >> 5;
    LAS float* wsf = (LAS float*)(lds + L_WS) + wid * 64;
    asm volatile("s_waitcnt vmcnt(0) lgkmcnt(0)" ::: "memory"); BAR();
    const bool active = D.nvis > 0;
    const int qtok = D.tok0 + (r32 & D.tmask), qcol = D.hcol0 + (r32 >> D.hshift) * 128;
    bf16x8 qr[NQ];
    {
        const bf16* qp = QN + (size_t)qtok * 4096 + qcol + hi * 8;
#pragma unroll
        for (int d0 = 0; d0 < 8; ++d0) qr[d0] = *(const bf16x8*)(qp + d0 * 16);
        if constexpr (KIND == 0) { const bf16* qp2 = QR + (size_t)qtok * 2048 + (qcol >> 1) + hi * 8;
#pragma unroll
            for (int d0 = 0; d0 < 4; ++d0) qr[8 + d0] = *(const bf16x8*)(qp2 + d0 * 16); }
    }
    const u64* mrow = MASK + (size_t)qtok * 128;
    int kn_off[2], v_off[2], kr_off = 0;
#pragma unroll
    for (int i = 0; i < 2; ++i) {
        const int row = 8 * wid + 4 * i + (lane >> 4), chunk = (lane & 15) ^ (row & 15); kn_off[i] = row * D.ldk + chunk * 8;
        const int kk = 8 * wid + ((lane & 31) >> 2), k = swap23(kk), c = 32 * (2 * i + (lane >> 5)) + (lane & 3) * 8; v_off[i] = k * D.ldv + c;
    }
    if constexpr (KIND == 0) { const int row = 8 * wid + (lane >> 3), chunk = (lane & 7) ^ ((row >> 1) & 7); kr_off = row * 64 + chunk * 8; }
#define STAGE(j, b, bv) do { const bf16* kb_ = D.K + (size_t)(j) * 64 * D.ldk; const bf16* vb_ = D.V + (size_t)(j) * 64 * D.ldv; \
        glds(kb_ + kn_off[0], lds + L_KN + (b) * 16384 + (2 * wid) * 1024); glds(kb_ + kn_off[1], lds + L_KN + (b) * 16384 + (2 * wid + 1) * 1024); \
        glds(vb_ + v_off[0], lds + L_V + (bv) * 16384 + (2 * wid) * 1024); glds(vb_ + v_off[1], lds + L_V + (bv) * 16384 + (2 * wid + 1) * 1024); \
        if constexpr (KIND == 0) glds(D.Kr + (size_t)(j) * 64 * 64 + kr_off, lds + L_KR + (b) * 8192 + wid * 1024); } while (0)
    const unsigned kq = (unsigned)(r32 * 256), kt = (unsigned)((hi ^ (r32 & 15)) << 4);
    const unsigned krq = (unsigned)(r32 * 128), krt = (unsigned)((hi ^ ((r32 >> 1) & 7)) << 4);
    const unsigned vb0 = (unsigned)(uintptr_t)(lds + L_V) + v_rd_base(lane);
    float lf = 0.f; f32x16 of[4];
    bool redo;
    {
        float l_reg = 0.f; f32x16 o[4];
    #pragma unroll
        for (int d = 0; d < 4; ++d)
    #pragma unroll
            for (int r = 0; r < 16; ++r) o[d][r] = 0.f;
        u64 mw_next = ~0ull;
        if constexpr (KIND == 1) mw_next = mrow[0];
        STAGE(0, 0, 0);
        const int half = wid >> 2; int vs = 0;
        bf16x8 pa0, pa1, pa2, pa3; { const bf16x8 z8 = {0, 0, 0, 0, 0, 0, 0, 0}; pa0 = z8; pa1 = z8; pa2 = z8; pa3 = z8; }
        for (int j = 0; j <= D.NT; ++j) {
            asm volatile("s_waitcnt vmcnt(0)" ::: "memory"); BAR();
            u64 mw = mw_next;
            const int vs1 = vs == 2 ? 0 : vs + 1, vsm = vs == 0 ? 2 : vs - 1;
            if (j + 1 < D.NT) { STAGE(j + 1, (j + 1) & 1, vs1); if constexpr (KIND == 1) mw_next = mrow[j + 1]; }
            if constexpr (KIND == 0) mw = (j == D.NT - 1) ? D.lastmask : ~0ull;
            if (half == 1 && j >= 1 && j - 1 < D.nvis) pv_all(o, vb0 + (unsigned)(vsm * 16384), pa0, pa1, pa2, pa3);
            if (j < D.NT && j < D.nvis) {
                const int b = j & 1;
                f32x16 p0, p1;
                {
                    LAS const unsigned char* kb = lds + L_KN + b * 16384 + kq;
                    constexpr int NSTEP = KIND == 0 ? 12 : 8;
                    bf16x8 ka0, ka1, kb0, kb1;
    #define KLOAD(d0_, X0, X1) do { if ((d0_) < 8) { const unsigned off_ = kt ^ (unsigned)((d0_) << 5); X0 = *(LAS const bf16x8*)(kb + off_); X1 = *(LAS const bf16x8*)(kb + 8192 + off_); } \
            else { LAS const unsigned char* kr_ = lds + L_KR + b * 8192 + krq; const unsigned off_ = krt ^ (unsigned)(((d0_) - 8) << 5); X0 = *(LAS const bf16x8*)(kr_ + off_); X1 = *(LAS const bf16x8*)(kr_ + 4096 + off_); } } while (0)
                    KLOAD(0, ka0, ka1);
    #pragma unroll
                    for (int d0 = 0; d0 < NSTEP; d0 += 2) {
                        KLOAD(d0 + 1, kb0, kb1);
                        if (d0 == 0) { const f32x16 z_ = {0.f, 0.f, 0.f, 0.f, 0.f, 0.f, 0.f, 0.f, 0.f, 0.f, 0.f, 0.f, 0.f, 0.f, 0.f, 0.f}; p0 = __builtin_amdgcn_mfma_f32_32x32x16_bf16(ka0, qr[0], z_, 0, 0, 0); p1 = __builtin_amdgcn_mfma_f32_32x32x16_bf16(ka1, qr[0], z_, 0, 0, 0); }
                        else { p0 = __builtin_amdgcn_mfma_f32_32x32x16_bf16(ka0, qr[d0], p0, 0, 0, 0); p1 = __builtin_amdgcn_mfma_f32_32x32x16_bf16(ka1, qr[d0], p1, 0, 0, 0); }
                        SBAR();
                        if (d0 + 2 < NSTEP) KLOAD(d0 + 2, ka0, ka1);
                        p0 = __builtin_amdgcn_mfma_f32_32x32x16_bf16(kb0, qr[d0 + 1], p0, 0, 0, 0); p1 = __builtin_amdgcn_mfma_f32_32x32x16_bf16(kb1, qr[d0 + 1], p1, 0, 0, 0); SBAR();
                    }
    #undef KLOAD
                }
                float ps = 0.f;
    #pragma unroll
                for (int r = 0; r < 16; ++r) { p0[r] = __builtin_amdgcn_exp2f(p0[r]); p1[r] = __builtin_amdgcn_exp2f(p1[r]); }
                if (KIND == 1 || mw != ~0ull) {
                    const unsigned lo = (unsigned)mw >> (4 * hi), hh = (unsigned)(mw >> 32) >> (4 * hi);
    #pragma unroll
                    for (int r = 0; r < 16; ++r) { const int bit = (r & 3) + 8 * (r >> 2);
                        p0[r] = __uint_as_float(__float_as_uint(p0[r]) & (unsigned)__builtin_amdgcn_sbfe((int)lo, bit, 1));
                        p1[r] = __uint_as_float(__float_as_uint(p1[r]) & (unsigned)__builtin_amdgcn_sbfe((int)hh, bit, 1)); }
                }
    #pragma unroll
                for (int r = 0; r < 16; ++r) ps += p0[r] + p1[r];
                { auto rr = __builtin_amdgcn_permlane32_swap(__float_as_uint(ps), __float_as_uint(ps), false, false); ps = __uint_as_float(rr[0]) + __uint_as_float(rr[1]); }
                l_reg += ps;
    #define PK4(P, BASE, OUT) do { unsigned a0 = cvtpk(P[BASE + 0], P[BASE + 1]), a1 = cvtpk(P[BASE + 2], P[BASE + 3]); \
        unsigned b0 = cvtpk(P[BASE + 4], P[BASE + 5]), b1 = cvtpk(P[BASE + 6], P[BASE + 7]); \
        auto r0 = __builtin_amdgcn_permlane32_swap(a0, b0, false, false); auto r1 = __builtin_amdgcn_permlane32_swap(a1, b1, false, false); \
        u32x4 w = {r0[0], r1[0], r0[1], r1[1]}; OUT = __builtin_bit_cast(bf16x8, w); } while (0)
                PK4(p0, 0, pa0); PK4(p0, 8, pa1); PK4(p1, 0, pa2); PK4(p1, 8, pa3);
    #undef PK4
                if (half == 0) pv_all(o, vb0 + (unsigned)(vs * 16384), pa0, pa1, pa2, pa3);
            }
            vs = vs1;
        }
        bool ok = l_reg > 1e-30f && l_reg < 1e30f;
#pragma unroll
        for (int d = 0; d < 4; ++d)
#pragma unroll
            for (int r = 0; r < 16; ++r) ok = ok && (fabsf(o[d][r]) < 1e30f);
        const bool bad = active && !__all(ok);
        if (!bad) { lf = l_reg;
#pragma unroll
            for (int d = 0; d < 4; ++d) of[d] = o[d]; }
        LAS unsigned* flags = (LAS unsigned*)(lds + L_END);
        if (lane == 0) flags[wid] = bad ? 1u : 0u;
        asm volatile("s_waitcnt vmcnt(0) lgkmcnt(0)" ::: "memory"); BAR();
        unsigned any = 0;
#pragma unroll
        for (int w = 0; w < 8; ++w) any |= flags[w];
        redo = any != 0u;
    }
    if (__builtin_expect(redo, 0)) {
        asm volatile("s_waitcnt vmcnt(0) lgkmcnt(0)" ::: "memory"); BAR();
        float l_reg = 0.f; f32x16 o[4];
        f32x16 negm;
    #pragma unroll
        for (int r = 0; r < 16; ++r) negm[r] = 0.f;
    #pragma unroll
        for (int d = 0; d < 4; ++d)
    #pragma unroll
            for (int r = 0; r < 16; ++r) o[d][r] = 0.f;
        u64 mw_next = ~0ull;
        if constexpr (KIND == 1) mw_next = mrow[0];
        STAGE(0, 0, 0);
        for (int j = 0; j < D.NT; ++j) {
            asm volatile("s_waitcnt vmcnt(0)" ::: "memory"); BAR();
            u64 mw = mw_next;
            if (j + 1 < D.NT) { STAGE(j + 1, (j + 1) & 1, (j + 1) % 3); if constexpr (KIND == 1) mw_next = mrow[j + 1]; }
            if constexpr (KIND == 0) mw = (j == D.NT - 1) ? D.lastmask : ~0ull;
            if (j < D.nvis) {
                const int b = j & 1;
                f32x16 p0, p1;
                {
                    LAS const unsigned char* kb = lds + L_KN + b * 16384 + kq;
                    constexpr int NSTEP = KIND == 0 ? 12 : 8;
                    bf16x8 ka0, ka1, kb0, kb1;
    #define KLOAD(d0_, X0, X1) do { if ((d0_) < 8) { const unsigned off_ = kt ^ (unsigned)((d0_) << 5); X0 = *(LAS const bf16x8*)(kb + off_); X1 = *(LAS const bf16x8*)(kb + 8192 + off_); } \
            else { LAS const unsigned char* kr_ = lds + L_KR + b * 8192 + krq; const unsigned off_ = krt ^ (unsigned)(((d0_) - 8) << 5); X0 = *(LAS const bf16x8*)(kr_ + off_); X1 = *(LAS const bf16x8*)(kr_ + 4096 + off_); } } while (0)
                    KLOAD(0, ka0, ka1);
    #pragma unroll
                    for (int d0 = 0; d0 < NSTEP; d0 += 2) {
                        KLOAD(d0 + 1, kb0, kb1);
                        if (d0 == 0) { p0 = __builtin_amdgcn_mfma_f32_32x32x16_bf16(ka0, qr[0], negm, 0, 0, 0); p1 = __builtin_amdgcn_mfma_f32_32x32x16_bf16(ka1, qr[0], negm, 0, 0, 0); }
                        else { p0 = __builtin_amdgcn_mfma_f32_32x32x16_bf16(ka0, qr[d0], p0, 0, 0, 0); p1 = __builtin_amdgcn_mfma_f32_32x32x16_bf16(ka1, qr[d0], p1, 0, 0, 0); }
                        SBAR();
                        if (d0 + 2 < NSTEP) KLOAD(d0 + 2, ka0, ka1);
                        p0 = __builtin_amdgcn_mfma_f32_32x32x16_bf16(kb0, qr[d0 + 1], p0, 0, 0, 0); p1 = __builtin_amdgcn_mfma_f32_32x32x16_bf16(kb1, qr[d0 + 1], p1, 0, 0, 0); SBAR();
                    }
    #undef KLOAD
                }
                float pmax = fmaxf(fmaxf(p0[0], p0[1]), p0[2]);
    #pragma unroll
                for (int r = 3; r < 15; r += 2) pmax = fmaxf(fmaxf(pmax, p0[r]), p0[r + 1]);
                pmax = fmaxf(pmax, p0[15]);
    #pragma unroll
                for (int r = 0; r < 16; r += 2) pmax = fmaxf(fmaxf(pmax, p1[r]), p1[r + 1]);
                { auto rr = __builtin_amdgcn_permlane32_swap(__float_as_uint(pmax), __float_as_uint(pmax), false, false); pmax = fmaxf(__uint_as_float(rr[0]), __uint_as_float(rr[1])); }
                float alpha = 1.f;
                if (!__all(pmax <= 8.0f)) {
                    const float d = fmaxf(pmax, 0.f); alpha = __builtin_amdgcn_exp2f(-d);
    #pragma unroll
                    for (int r = 0; r < 16; ++r) { p0[r] -= d; p1[r] -= d; negm[r] -= d; }
                }
                float ps = 0.f;
    #pragma unroll
                for (int r = 0; r < 16; ++r) { p0[r] = __builtin_amdgcn_exp2f(p0[r]); p1[r] = __builtin_amdgcn_exp2f(p1[r]); }
                if (KIND == 1 || mw != ~0ull) {
                    const unsigned lo = (unsigned)mw >> (4 * hi), hh = (unsigned)(mw >> 32) >> (4 * hi);
    #pragma unroll
                    for (int r = 0; r < 16; ++r) { const int bit = (r & 3) + 8 * (r >> 2);
                        p0[r] = __uint_as_float(__float_as_uint(p0[r]) & (unsigned)__builtin_amdgcn_sbfe((int)lo, bit, 1));
                        p1[r] = __uint_as_float(__float_as_uint(p1[r]) & (unsigned)__builtin_amdgcn_sbfe((int)hh, bit, 1)); }
                }
    #pragma unroll
                for (int r = 0; r < 16; ++r) ps += p0[r] + p1[r];
                { auto rr = __builtin_amdgcn_permlane32_swap(__float_as_uint(ps), __float_as_uint(ps), false, false); ps = __uint_as_float(rr[0]) + __uint_as_float(rr[1]); }
                l_reg = l_reg * alpha + ps;
                bf16x8 pa0, pa1, pa2, pa3;
    #define PK4(P, BASE, OUT) do { unsigned a0 = cvtpk(P[BASE + 0], P[BASE + 1]), a1 = cvtpk(P[BASE + 2], P[BASE + 3]); \
        unsigned b0 = cvtpk(P[BASE + 4], P[BASE + 5]), b1 = cvtpk(P[BASE + 6], P[BASE + 7]); \
        auto r0 = __builtin_amdgcn_permlane32_swap(a0, b0, false, false); auto r1 = __builtin_amdgcn_permlane32_swap(a1, b1, false, false); \
        u32x4 w = {r0[0], r1[0], r0[1], r1[1]}; OUT = __builtin_bit_cast(bf16x8, w); } while (0)
                PK4(p0, 0, pa0); PK4(p0, 8, pa1); PK4(p1, 0, pa2); PK4(p1, 8, pa3);
    #undef PK4
                if (__any(alpha < 1.f)) {
                    if (hi == 0) wsf[32 + r32] = alpha;
                    asm volatile("s_waitcnt lgkmcnt(0)" ::: "memory");
    #pragma unroll
                    for (int r = 0; r < 16; ++r) { const float a = wsf[32 + crow(r, hi)];
    #pragma unroll
                        for (int d = 0; d < 4; ++d) o[d][r] *= a; }
                }
                const unsigned vb = vb0 + (unsigned)((j % 3) * 16384);
                pv_all(o, vb, pa0, pa1, pa2, pa3);
            }
        }

#undef STAGE
        lf = l_reg;
#pragma unroll
        for (int d = 0; d < 4; ++d) of[d] = o[d];
        asm volatile("s_waitcnt vmcnt(0) lgkmcnt(0)" ::: "memory"); BAR();
    }
    if (active) {
        if (hi == 0) wsf[r32] = lf;
        asm volatile("s_waitcnt lgkmcnt(0)" ::: "memory");
        LAS unsigned char* ost = lds + wid * 8192;
#pragma unroll
        for (int r = 0; r < 16; ++r) { const float rl = __builtin_amdgcn_rcpf(wsf[crow(r, hi)]); const int row = crow(r, hi);
#pragma unroll
            for (int d = 0; d < 4; ++d) *(LAS unsigned short*)(ost + row * 256 + (32 * d + r32) * 2) = (unsigned short)f2bf(of[d][r] * rl); }
        asm volatile("s_waitcnt lgkmcnt(0)" ::: "memory");
#pragma unroll
        for (int i = 0; i < 8; ++i) {
            const int lr = 4 * i + (lane >> 4), cc = (lane & 15) * 8;
            if (lr < D.nvalid) {
                const bf16x8 ov = *(LAS const bf16x8*)(ost + lr * 256 + cc * 2);
                const size_t idx = (size_t)(D.tok0 + (lr & D.tmask)) * 4096 + D.hcol0 + (lr >> D.hshift) * 128 + cc;
                const bf16x8 g = *(const bf16x8*)(GATE + idx);
                bf16x8 ab; if constexpr (KIND == 1) ab = *(const bf16x8*)(ADDB + idx);
                u32x4 w;
#pragma unroll
                for (int e = 0; e < 4; ++e) {
                    float x0 = bf2f((unsigned short)ov[2 * e]) * bf2f((unsigned short)g[2 * e]), x1 = bf2f((unsigned short)ov[2 * e + 1]) * bf2f((unsigned short)g[2 * e + 1]);
                    if constexpr (KIND == 1) { x0 += bf2f((unsigned short)ab[2 * e]); x1 += bf2f((unsigned short)ab[2 * e + 1]); }
                    w[e] = pk2(x0, x1);
                }
                *(u32x4*)(OUT + idx) = w;
            }
        }
    }
}

__device__ __forceinline__ void idx_unit(LAS unsigned char* lds, const bf16* QI, const float* WI, const bf16* KI, int tok0, int NT, int nvalid, float* srow0, size_t spitch, int wid, int lane) {
    asm volatile("" : "+v"(lane));
    const int r32 = lane & 31, hi = lane >> 5;
    asm volatile("s_waitcnt vmcnt(0) lgkmcnt(0)" ::: "memory"); BAR();
    bf16x8 qa[2][8]; float wv[2][16];
#pragma unroll
    for (int t = 0; t < 2; ++t) { const int tok = tok0 + 2 * wid + t; const bf16* qp = QI + (size_t)tok * 4096 + r32 * 128 + hi * 8;
#pragma unroll
        for (int d0 = 0; d0 < 8; ++d0) qa[t][d0] = *(const bf16x8*)(qp + d0 * 16);
#pragma unroll
        for (int r = 0; r < 16; ++r) wv[t][r] = WI[(size_t)tok * 32 + crow(r, hi)]; }
    int kn_off[2];
#pragma unroll
    for (int i = 0; i < 2; ++i) { const int row = 8 * wid + 4 * i + (lane >> 4), chunk = (lane & 15) ^ (row & 15); kn_off[i] = row * 128 + chunk * 8; }
#define ISTAGE2(J, b) do { const bf16* kb_ = KI + (size_t)(J) * 128 * 128; glds(kb_ + kn_off[0], lds + (b) * 32768 + (2 * wid) * 1024); glds(kb_ + kn_off[1], lds + (b) * 32768 + (2 * wid + 1) * 1024); \
        if (2 * (J) + 1 < NT) { glds(kb_ + 8192 + kn_off[0], lds + (b) * 32768 + 16384 + (2 * wid) * 1024); glds(kb_ + 8192 + kn_off[1], lds + (b) * 32768 + 16384 + (2 * wid + 1) * 1024); } } while (0)
    const unsigned kq = (unsigned)(r32 * 256), kt = (unsigned)((hi ^ (r32 & 15)) << 4);
    float* s0 = srow0 + (size_t)(2 * wid) * spitch; float* s1 = s0 + spitch;
    const int NS2 = (NT + 1) >> 1;
    ISTAGE2(0, 0);
    for (int J = 0; J < NS2; ++J) {
        if (J == 0) asm volatile("s_waitcnt vmcnt(0)" ::: "memory");
        else asm volatile("s_waitcnt vmcnt(4)" ::: "memory");
        BAR();
        if (J + 1 < NS2) ISTAGE2(J + 1, (J + 1) & 1);
        const int nq = (2 * J + 1 < NT) ? 4 : 2;
        const unsigned kba = (unsigned)(size_t)(lds + (J & 1) * 32768 + kq);
        bf16x8 kfa[8], kfb[8];
        float sc[2][4];
#define IREAD(KF, Q) do { _Pragma("unroll") for (int d0 = 0; d0 < 8; ++d0) asm volatile("ds_read_b128 %0, %1 offset:%2" : "=v"(KF[d0]) : "v"(kba + (kt ^ (unsigned)(d0 << 5))), "i"((Q) * 8192) : "memory"); } while (0)
#define IMMA(ACC, KF, T) do { _Pragma("unroll") for (int r = 0; r < 16; ++r) ACC[r] = 0.f; \
            _Pragma("unroll") for (int d0 = 0; d0 < 8; ++d0) ACC = __builtin_amdgcn_mfma_f32_32x32x16_bf16(qa[T][d0], KF[d0], ACC, 0, 0, 0); } while (0)
#define IRED(ACC, T, Q) do { float s_ = 0.f; \
            _Pragma("unroll") for (int r = 0; r < 16; ++r) s_ += __builtin_amdgcn_fmed3f(ACC[r], 0.f, 3.0e38f) * wv[T][r]; \
            auto rr_ = __builtin_amdgcn_permlane32_swap(__float_as_uint(s_), __float_as_uint(s_), false, false); \
            sc[T][Q] = __uint_as_float(rr_[0]) + __uint_as_float(rr_[1]); } while (0)
        f32x16 accA, accB;
        IREAD(kfa, 0);
        IREAD(kfb, 1); asm volatile("s_waitcnt lgkmcnt(8)" ::: "memory"); SBAR();
        IMMA(accA, kfa, 0); SBAR();
        IMMA(accB, kfa, 1); IRED(accA, 0, 0); SBAR();
        if (nq == 4) { IREAD(kfa, 2); asm volatile("s_waitcnt lgkmcnt(8)" ::: "memory"); } else asm volatile("s_waitcnt lgkmcnt(0)" ::: "memory");
        SBAR();
        IMMA(accA, kfb, 0); IRED(accB, 1, 0); SBAR();
        IMMA(accB, kfb, 1); IRED(accA, 0, 1); SBAR();
        if (nq == 4) {
            IREAD(kfb, 3); asm volatile("s_waitcnt lgkmcnt(8)" ::: "memory"); SBAR();
            IMMA(accA, kfa, 0); IRED(accB, 1, 1); SBAR();
            {
                const int j = 2 * J; const bool kv = j * 64 + lane < nvalid;
                s0[j * 64 + lane] = kv ? (hi ? sc[0][1] : sc[0][0]) : -INFINITY;
                s1[j * 64 + lane] = kv ? (hi ? sc[1][1] : sc[1][0]) : -INFINITY;
            }
            IMMA(accB, kfa, 1); IRED(accA, 0, 2); SBAR();
            asm volatile("s_waitcnt lgkmcnt(0)" ::: "memory"); SBAR();
            IMMA(accA, kfb, 0); IRED(accB, 1, 2); SBAR();
            IMMA(accB, kfb, 1); IRED(accA, 0, 3); SBAR();
            IRED(accB, 1, 3);
            const int j = 2 * J + 1; const bool kv = j * 64 + lane < nvalid;
            s0[j * 64 + lane] = kv ? (hi ? sc[0][3] : sc[0][2]) : -INFINITY;
            s1[j * 64 + lane] = kv ? (hi ? sc[1][3] : sc[1][2]) : -INFINITY;
        } else {
            IRED(accB, 1, 1);
            const int j = 2 * J; const bool kv = j * 64 + lane < nvalid;
            s0[j * 64 + lane] = kv ? (hi ? sc[0][1] : sc[0][0]) : -INFINITY;
            s1[j * 64 + lane] = kv ? (hi ? sc[1][1] : sc[1][0]) : -INFINITY;
        }
    }
#undef IMMA
#undef IRED
#undef IREAD
#undef ISTAGE2
    for (int j = NT * 64 + lane; j < (int)spitch; j += 64) { s0[j] = -INFINITY; s1[j] = -INFINITY; }
}

__device__ __forceinline__ unsigned okey(float f) { const unsigned u = __float_as_uint(f); return (u & 0x80000000u) ? ~u : (u | 0x80000000u); }
template <int NS> __device__ __forceinline__ void topk_wave(const float* srow, u64* mrow, int lane) {
    asm volatile("" : "+v"(lane));
    unsigned key[NS];
    {
        unsigned long long base = (unsigned long long)srow;
#pragma unroll
        for (int j0 = 0; j0 < NS; j0 += 16) {
            asm volatile("" : "+s"(base));
            const float* b = (const float*)base + lane;
#pragma unroll
            for (int jj = 0; jj < 16; ++jj) key[j0 + jj] = okey(b[jj * 64]);
            base += 4096;
        }
    }
    unsigned T = 0u; bool exact = false;
    for (int bit = 31; bit >= 0; --bit) {
        const unsigned cand = T | (1u << bit); unsigned tot = 0;
#pragma unroll
        for (int j = 0; j < NS; ++j) { tot += (unsigned)__builtin_popcountll(__ballot(key[j] >= cand)); if ((j & 7) == 7) SBAR(); }
        if (tot >= 256u) T = cand;
        if (tot == 256u) { exact = true; break; }
    }
    T = (unsigned)__builtin_amdgcn_readfirstlane((int)T);
    if (exact) {
        u64* mp = mrow; asm volatile("" : "+v"(mp));
#pragma unroll
        for (int j = 0; j < NS; ++j) { const u64 m = __ballot(key[j] >= T); if (lane == 0) mp[j] = m; if ((j & 3) == 3) SBAR(); }
    } else {
        unsigned gt = 0;
        for (int j = 0; j < NS; ++j) gt += (unsigned)__builtin_popcountll(__ballot(okey(srow[64 * j + lane]) > T));
        int need = 256 - (int)gt;
        for (int j = 0; j < NS; ++j) {
            const unsigned k = okey(srow[64 * j + lane]); const u64 g = __ballot(k > T); u64 e = __ballot(k == T);
            while ((int)__builtin_popcountll(e) > need) e &= ~(1ull << (63 - __builtin_clzll(e)));
            need -= (int)__builtin_popcountll(e);
            if (lane == 0) mrow[j] = g | e;
        }
    }
}
__device__ __forceinline__ void topk_row_wave(const float* srow, int n, int pitch, u64* mrow, int lane) {
    if (n <= 256) { const int nt = (n + 63) >> 6; if (lane < nt) mrow[lane] = ~0ull; return; }
    if (pitch == 1024) topk_wave<16>(srow, mrow, lane);
    else if (pitch == 2048) topk_wave<32>(srow, mrow, lane);
    else if (pitch == 4096) topk_wave<64>(srow, mrow, lane);
    else topk_wave<128>(srow, mrow, lane);
}
#undef SBAR
#undef BAR
}

__device__ const unsigned short IDX_UNITS[512] = {2, 451, 3, 452, 1, 448, 0, 450, 42, 411, 33, 416, 104, 343, 18, 434, 74, 375, 4, 442, 70, 378, 11, 441, 77, 369, 14, 437, 120, 325, 94, 353, 13, 507, 16, 501, 15, 506, 9, 504, 8, 505, 5, 509, 23, 496, 6, 508, 27, 495, 34, 487, 12, 503, 30, 488, 21, 497, 19, 502, 7, 511, 20, 499, 36, 482, 43, 476, 38, 481, 31, 490, 45, 474, 24, 492, 55, 469, 10, 510, 25, 493, 29, 491, 53, 466, 72, 444, 58, 463, 61, 457, 44, 477, 51, 472, 17, 500, 39, 484, 41, 480, 46, 479, 63, 459, 26, 494, 54, 467, 50, 475, 62, 461, 52, 470, 47, 473, 56, 464, 59, 462, 35, 486, 71, 449, 65, 458, 22, 498, 57, 465, 28, 489, 48, 468, 60, 460, 37, 483, 40, 478, 32, 485, 49, 471, 66, 456, 73, 447, 79, 443, 67, 453, 69, 454, 82, 439, 64, 455, 76, 438, 68, 445, 75, 446, 78, 440, 81, 435, 91, 427, 80, 436, 87, 433, 84, 430, 88, 425, 90, 431, 95, 421, 93, 423, 83, 432, 96, 417, 86, 429, 107, 414, 92, 426, 89, 424, 99, 420, 100, 419, 103, 415, 98, 422, 101, 413, 109, 406, 97, 418, 102, 412, 106, 410, 110, 407, 111, 409, 105, 408, 108, 405, 115, 403, 85, 428, 114, 400, 112, 404, 130, 389, 121, 397, 118, 401, 117, 398, 113, 402, 129, 390, 126, 393, 116, 399, 124, 391, 119, 396, 123, 392, 122, 394, 131, 385, 133, 382, 125, 395, 127, 388, 132, 386, 137, 383, 135, 384, 128, 387, 134, 381, 139, 380, 143, 374, 140, 373, 138, 379, 142, 376, 136, 377, 150, 364, 149, 365, 147, 370, 146, 371, 156, 359, 148, 366, 145, 367, 153, 361, 141, 372, 144, 368, 157, 357, 155, 363, 154, 362, 163, 349, 159, 356, 164, 346, 151, 360, 162, 352, 152, 358, 170, 345, 174, 342, 167, 350, 166, 347, 165, 348, 160, 354, 158, 355, 169, 340, 161, 351, 171, 344, 178, 337, 173, 339, 172, 336, 168, 341, 181, 333, 179, 332, 175, 338, 176, 335, 182, 330, 180, 328, 183, 329, 177, 334, 185, 326, 186, 331, 187, 324, 184, 327, 189, 321, 190, 323, 188, 322, 191, 320, 192, 317, 194, 319, 195, 318, 193, 316, 199, 312, 198, 313, 196, 315, 197, 314, 200, 309, 203, 311, 201, 310, 202, 308, 204, 304, 206, 306, 207, 305, 205, 307, 209, 303, 208, 302, 210, 301, 211, 300, 215, 299, 214, 297, 213, 298, 212, 296, 217, 293, 219, 294, 216, 295, 218, 292, 221, 289, 223, 290, 222, 291, 220, 288, 227, 285, 225, 284, 226, 286, 224, 287, 230, 281, 229, 283, 231, 282, 228, 280, 235, 276, 233, 278, 234, 279, 232, 277, 236, 274, 237, 272, 238, 273, 239, 275, 243, 269, 242, 270, 241, 268, 240, 271, 246, 264, 244, 265, 247, 267, 245, 266, 251, 263, 248, 260, 249, 262, 250, 261, 252, 256, 253, 257, 255, 258, 254, 259};
__device__ __forceinline__ void p5_mla_and_indexer(const Ctx& C) {
    unsigned char* ws = C.ws; const int w = C.wave;
    const bf16* QAN = (const bf16*)(ws + WS_QAN); const bf16* QAR = (const bf16*)(ws + WS_QAR); const bf16* KN = (const bf16*)(ws + WS_KN); const bf16* VM = (const bf16*)(ws + WS_VM);
    const bf16* KRP = (const bf16*)(ws + WS_KROPE); const bf16* SGA = (const bf16*)(ws + WS_SGA); bf16* OUTA = (bf16*)(ws + WS_OUTA);
    const bf16* QI = (const bf16*)(ws + WS_QI); const bf16* KI = (const bf16*)(ws + WS_KI); const float* WI = (const float*)(ws + WS_WI); float* SC = (float*)(ws + WS_SCORE);
    for (int v = C.bx; v < 256; v += C.G) {
        const int x = v & 7, jj = v >> 3;
        for (int k = 0; k < 4; ++k) {
            const int h = x + 8 * k, qb = (k & 1) ? 31 - jj : jj;
            att::Desc D; D.K = KN + h * 128; D.ldk = 4096; D.Kr = KRP; D.V = VM + h * 128; D.ldv = 4096; D.NT = 4 * (qb + 1); D.nvis = 4 * qb + (w >> 1) + 1; D.lastmask = ~0ull;
            D.tok0 = 256 * qb + 32 * w; D.tmask = 31; D.hshift = 5; D.hcol0 = h * 128; D.nvalid = 32;
            att::attn_unit<0>(C.lds, D, QAN, QAR, nullptr, SGA, nullptr, OUTA, w, C.lane);
        }
        for (int k = 0; k < 2; ++k) {
            const int su = v + 256 * k, b = su >> 5, h = su & 31; const size_t kr0 = (size_t)SEQ + (size_t)b * SPITCH;
            att::Desc D; D.K = KN + kr0 * 4096 + h * 128; D.ldk = 4096; D.Kr = KRP + kr0 * 64; D.V = VM + kr0 * 4096 + h * 128; D.ldv = 4096; D.NT = 17; D.nvis = (w == 0) ? 17 : 0; D.lastmask = 0xFFFFull;
            D.tok0 = SEQ + 16 * b; D.tmask = 15; D.hshift = 5; D.hcol0 = h * 128; D.nvalid = 16;
            att::attn_unit<0>(C.lds, D, QAN, QAR, nullptr, SGA, nullptr, OUTA, w, C.lane);
        }
    }
    for (int v = C.bx; v < 256; v += C.G) {
        for (int k = 0; k < 2; ++k) {
            const int un = IDX_UNITS[v * 2 + k], c = un >> 2, tg = un & 3; const size_t pitch = (size_t)score_pitch(c);
            att::idx_unit(C.lds, QI, WI, KI, 64 * c + 16 * tg, c + 1, 64 * (c + 1), SC + score_chunk_off(c) + (size_t)(16 * tg) * pitch, pitch, w, C.lane);
        }
        if (v < DEC_B) att::idx_unit(C.lds, QI, WI, KI + ((size_t)SEQ + (size_t)v * SPITCH) * 128, SEQ + 16 * v, 17, SKEYS, SC + SCORE_P_FLOATS + (size_t)(16 * v) * SPITCH_SC, SPITCH_SC, w, C.lane);
    }
    asm volatile("s_waitcnt vmcnt(0) lgkmcnt(0)" ::: "memory"); __syncthreads();
}
__device__ __forceinline__ void p6_topk(const Ctx& C) {
    const float* SC = (const float*)(C.ws + WS_SCORE); att::u64* MASK = (att::u64*)(C.ws + WS_MASK);
    const int gw = C.bx * NWAVES + C.wave, NGW = C.G * NWAVES;
    for (int r = gw; r < NROW; r += NGW) {
        int n, pitch; const float* srow;
        if (r < SEQ) { const int c = r >> 6; n = 64 * (c + 1); pitch = score_pitch(c); srow = SC + score_chunk_off(c) + (size_t)(r & 63) * pitch; }
        else { n = SKEYS; pitch = SPITCH_SC; srow = SC + SCORE_P_FLOATS + (size_t)(r - SEQ) * SPITCH_SC; }
        att::topk_row_wave(srow, n, pitch, MASK + (size_t)r * 128, C.lane);
    }
}
__device__ const unsigned char DSA_CHUNKS[128] = {1, 115, 63, 66, 2, 118, 64, 61, 0, 110, 60, 75, 12, 104, 62, 68, 3, 119, 57, 67, 13, 102, 58, 73, 6, 124, 56, 59, 8, 100, 65, 72, 7, 117, 52, 69, 9, 114, 53, 70, 5, 123, 46, 71, 4, 126, 38, 77, 11, 105, 55, 74, 15, 107, 42, 81, 14, 103, 49, 80, 16, 96, 54, 79, 10, 120, 51, 82, 17, 121, 48, 76, 18, 111, 50, 84, 19, 127, 31, 86, 25, 116, 44, 78, 20, 125, 29, 89, 22, 113, 41, 87, 23, 112, 43, 85, 21, 109, 37, 95, 28, 122, 30, 83, 26, 99, 45, 92, 24, 101, 47, 91, 27, 108, 35, 93, 39, 97, 33, 94, 32, 106, 36, 88, 40, 98, 34, 90};
__device__ __forceinline__ void p7_dsa(const Ctx& C) {
    unsigned char* ws = C.ws; const int w = C.wave;
    const bf16* QB = (const bf16*)(ws + WS_QB); const bf16* KA = (const bf16*)(ws + WS_KALL); const bf16* VA = (const bf16*)(ws + WS_VALL);
    const att::u64* MASK = (const att::u64*)(ws + WS_MASK); const bf16* SGB = (const bf16*)(ws + WS_SGB); const bf16* OUTA = (const bf16*)(ws + WS_OUTA); bf16* MG = (bf16*)(ws + WS_MERGED);
    for (int v = C.bx; v < 256; v += C.G) {
        const int g = v & 7, jj = v >> 3;
        for (int k = 0; k < 4; ++k) {
            const int c = DSA_CHUNKS[jj * 4 + k];
            att::Desc D; D.K = KA + g * 128; D.ldk = 1024; D.Kr = nullptr; D.V = VA + g * 128; D.ldv = 1024; D.NT = c + 1; D.nvis = c + 1; D.lastmask = ~0ull;
            D.tok0 = 64 * c + 32 * (w & 1); D.tmask = 31; D.hshift = 5; D.hcol0 = (4 * g + (w >> 1)) * 128; D.nvalid = 32;
            att::attn_unit<1>(C.lds, D, QB, nullptr, MASK, SGB, OUTA, MG, w, C.lane);
        }
        if (v < DEC_B * NKV) {
            const int b = v >> 3; const size_t kr0 = (size_t)SEQ + (size_t)b * SPITCH;
            att::Desc D; D.K = KA + kr0 * 1024 + g * 128; D.ldk = 1024; D.Kr = nullptr; D.V = VA + kr0 * 1024 + g * 128; D.ldv = 1024; D.NT = 17; D.nvis = (w < 2) ? 17 : 0; D.lastmask = ~0ull;
            D.tok0 = SEQ + 16 * b; D.tmask = 15; D.hshift = 4; D.hcol0 = (4 * g + 2 * w) * 128; D.nvalid = 32;
            att::attn_unit<1>(C.lds, D, QB, nullptr, MASK, SGB, OUTA, MG, w, C.lane);
        }
    }
    asm volatile("s_waitcnt vmcnt(0) lgkmcnt(0)" ::: "memory"); __syncthreads();
}


constexpr int N_PHASES = 13;
__global__ void __launch_bounds__(NWAVES * 64, 2) fwd_kernel(Args args) {
    extern __shared__ __attribute__((aligned(16))) unsigned char lds_raw[];
    Ctx C; C.lds = (LAS unsigned char*)lds_raw; C.a = &args; C.ws = args.ws; C.out = args.out;
    C.tid = threadIdx.x; C.lane = C.tid & 63; C.wave = __builtin_amdgcn_readfirstlane(C.tid >> 6); C.G = gridDim.x; C.bx = blockIdx.x;
    volatile LAS unsigned* MISC = (volatile LAS unsigned*)(C.lds + MISC_OFF);
    for (int u = C.tid; u < (LDS_BYTES - LDSCTL_OFF) / 4; u += NWAVES * 64) ((LAS unsigned*)(C.lds + LDSCTL_OFF))[u] = 0u;
    __syncthreads();
    unsigned* ctl = (unsigned*)(args.ws + WS_CTL);
    XcdBarrier bar; bar.bar = ctl + CW_BAR; bar.x = 0; bar.st = nullptr;
    if (MK_N_LAUNCHES == 1) bar = xcd_barrier_post(ctl + CW_BAR, MISC + 8);
    const int lo = args.ph_lo, hi = args.ph_hi;
#ifndef PH_MASK
#define PH_MASK 0xFFFFFFFFu
#endif
#define IN(k) (((PH_MASK >> (k)) & 1) && lo <= (k) && (k) < hi)
#define SEAM(k) do { if (IN(k) && IN((k) + 1)) xcd_barrier(bar); } while (0)
    unsigned char* ws = args.ws;
    PG8_LAS unsigned char* ring = (PG8_LAS unsigned char*)lds_raw;

    if (IN(0)) { p01_gemv_and_copies(C); SEAM(0); }
    if (IN(1)) { p1_modnorm(C); SEAM(1); }
    if (IN(2)) {
        pg8::Gemm g{(const pg8::bf16_t*)(ws + WS_XN), (const pg8::bf16_t*)(ws + WS_WIN), NROW, DINP, DM}; pg8::StaticOrder S; S.init(NROW, DINP, C.G, C.bx);
        const float* rp = (const float*)(ws + WS_ROPE);
        pg8::EpiIn E{(float*)(ws + WS_QRAW), (float*)(ws + WS_CKVRAW), (pg8::bf16_t*)(ws + WS_QB), (pg8::bf16_t*)(ws + WS_QI), (pg8::bf16_t*)(ws + WS_SGA), (pg8::bf16_t*)(ws + WS_SGB),
                     (pg8::bf16_t*)(ws + WS_KALL), (pg8::bf16_t*)(ws + WS_VALL), (pg8::bf16_t*)(ws + WS_KI), (pg8::bf16_t*)(ws + WS_KROPE), (float*)(ws + WS_WI), args.out,
                     rp, rp + SEQ * 32, rp + SEQ * 64, rp + SEQ * 64 + SEQ * 16};
        S.lim = (S.nwg / C.G) * C.G;
        pg8::gemm_phase<pg8::EpiIn, pg8::StaticOrder, true, true>(ring, g, S, E);
        { pg8::TailHalfOrder T; T.init(NROW, DINP, C.G, C.bx); pg8::gemm_phase<pg8::EpiIn, pg8::TailHalfOrder, true, true, true>(ring, g, T, E); }
        SEAM(2);
    }
    if (IN(3)) { p3_norms(C); SEAM(3); }
    if (IN(4)) {
        {
            pg8::Gemm g{(const pg8::bf16_t*)(ws + WS_QN), (const pg8::bf16_t*)(ws + WS_WUQ), NROW, 6144, QLORA}; pg8::StaticOrder S; S.init(NROW, 6144, C.G, C.bx);
            const float* rp = (const float*)(ws + WS_ROPE);
            pg8::EpiUq E{(pg8::bf16_t*)(ws + WS_QAN), (pg8::bf16_t*)(ws + WS_QAR), rp, rp + SEQ * 32};
            pg8::gemm_phase<pg8::EpiUq, pg8::StaticOrder, true, true>(ring, g, S, E);
        }
        {
            pg8::Gemm g{(const pg8::bf16_t*)(ws + WS_CKV), (const pg8::bf16_t*)(ws + WS_WUKV), KROWS, 8192, KVLORA}; pg8::StaticOrder S; S.init(KROWS, 8192, C.G, (C.bx + C.G / 2) % C.G);
            pg8::EpiBf16<0> E{(pg8::bf16_t*)(ws + WS_KN), 4096, 4096, (WS_VM - WS_KN) / 2};
            pg8::gemm_phase<pg8::EpiBf16<0>, pg8::StaticOrder, true, true>(ring, g, S, E);
        }
        SEAM(4);
    }
    if (IN(5)) { p5_mla_and_indexer(C); SEAM(5); }
    if (IN(6)) { p6_topk(C); SEAM(6); }
    if (IN(7)) { p7_dsa(C); SEAM(7); }
    if (IN(8)) {
        pg8::Gemm g{(const pg8::bf16_t*)(ws + WS_MERGED), (const pg8::bf16_t*)(ws + WS_WOUT), NROW, DM, DM}; pg8::SampleSplitOrder S; S.init(SEQ, DM, DM, SPLIT_OUT, C.G, C.bx);
        pg8::EpiRes E{args.in[I_XP], args.in[I_XS], args.out + O_Y, (const float*)(ws + WS_ADA) + 2 * DM, (float*)(ws + WS_SLAB)};
        pg8::gemm_phase<pg8::EpiRes, pg8::SampleSplitOrder, true, true>(ring, g, S, E);
        SEAM(8);
    }
    if (IN(9)) { p9_h2(C); SEAM(9); }
    if (IN(10)) {
        pg8::Gemm g{(const pg8::bf16_t*)(ws + WS_XN), (const pg8::bf16_t*)(ws + WS_WUP), NROW, DFF, DM}; pg8::StaticOrder S; S.init(NROW, DFF, C.G, C.bx);
        pg8::EpiBf16<2> E{(pg8::bf16_t*)(ws + WS_U), DFF, 0, 0};
        S.lim = (S.nwg / C.G) * C.G;
        pg8::gemm_phase<pg8::EpiBf16<2>, pg8::StaticOrder, true, true>(ring, g, S, E);
        { pg8::TailHalfOrder T; T.init(NROW, DFF, C.G, C.bx); pg8::gemm_phase<pg8::EpiBf16<2>, pg8::TailHalfOrder, true, true, true>(ring, g, T, E); }
        SEAM(10);
    }
    if (IN(11)) {
        pg8::Gemm g{(const pg8::bf16_t*)(ws + WS_U), (const pg8::bf16_t*)(ws + WS_WDOWN), NROW, DM, DFF}; pg8::SampleSplitOrder S; S.init(SEQ, DM, DFF, SPLIT_DOWN, C.G, C.bx);
        pg8::EpiRes E{args.out + O_Y, args.out + O_Y + (size_t)SEQ * DM, args.out + O_Y, (const float*)(ws + WS_ADA) + 5 * DM, (float*)(ws + WS_SLAB)};
        pg8::gemm_phase<pg8::EpiRes, pg8::SampleSplitOrder, true, true>(ring, g, S, E);
        SEAM(11);
    }
    if (IN(12)) { p12_final(C); }
#undef IN
#undef SEAM
}

extern "C" void kernel_launch(void* const* d_in, const int* in_sizes, int n_in, void* d_out, int out_size, void* d_ws, size_t ws_size, hipStream_t stream) {
    static int grid = 0;
    if (grid == 0) {
        if (n_in != N_IN || in_sizes[I_XP] != SEQ * DM || in_sizes[I_WIN] != DM * DIN || (size_t)out_size != O_END || ws_size < WS_END) {
            fprintf(stderr, "kernel_launch: shape mismatch (n_in %d, out %d, ws %zu, need ws >= %zu); nothing launched\n", n_in, out_size, ws_size, (size_t)WS_END); grid = -1; return; }
        int dev = 0, cus = 0, per_cu = 0;
        if (hipGetDevice(&dev) != hipSuccess || hipDeviceGetAttribute(&cus, hipDeviceAttributeMultiprocessorCount, dev) != hipSuccess) { grid = -1; return; }
        if (hipFuncSetAttribute((const void*)fwd_kernel, hipFuncAttributeMaxDynamicSharedMemorySize, LDS_BYTES) != hipSuccess) { fprintf(stderr, "kernel_launch: hipFuncSetAttribute failed\n"); grid = -1; return; }
        if (hipOccupancyMaxActiveBlocksPerMultiprocessor(&per_cu, (const void*)fwd_kernel, NWAVES * 64, LDS_BYTES) != hipSuccess || per_cu < 1) { fprintf(stderr, "kernel_launch: occupancy query says %d\n", per_cu); }
        (void)hipGetLastError();
        grid = cus;
    }
    if (grid < 0) return;
    (void)hipMemsetAsync((char*)d_ws + WS_CTL, 0, CTL_ZERO_BYTES, stream);
    Args a{};
    for (int i = 0; i < N_IN; ++i) a.in[i] = (const float*)d_in[i];
    a.out = (float*)d_out; a.ws = (unsigned char*)d_ws;
    if (MK_N_LAUNCHES == 1) { a.ph_lo = 0; a.ph_hi = N_PHASES; a.li = 0; hipLaunchKernelGGL(fwd_kernel, dim3(grid), dim3(NWAVES * 64), LDS_BYTES, stream, a); }
    else {
        const int order[13] = {0, 1, 2, 3, 4, 5, 6, 7, 8, 9, 10, 11, 12};
        for (int q = 0; q < N_PHASES; ++q) { const int p = order[q]; a.ph_lo = p; a.ph_hi = p + 1; a.li = p; hipLaunchKernelGGL(fwd_kernel, dim3(grid), dim3(NWAVES * 64), LDS_BYTES, stream, a); }
    }
    const hipError_t le = hipPeekAtLastError();
    if (le != hipSuccess) fprintf(stderr, "kernel_launch: launch failed: %s\n", hipGetErrorName(le));
}
```

```cpp
#include <hip/hip_runtime.h>
#include <cstdio>
#include <cstdint>

#ifndef MK_N_LAUNCHES
#define MK_N_LAUNCHES 1
#endif

constexpr int DM = 4096, SEQ = 8192, NSAMP = 256, NROW = SEQ + NSAMP;
constexpr int DEC_B = 16, DEC_S = 16, PAST = 1024, SKEYS = PAST + DEC_S, SPITCH = 1088;
constexpr int KROWS = SEQ + DEC_B * SPITCH;
constexpr int DIN = 20192, DINP = 20224, DFF = 16384, NADA = 6 * DM, NVEC = 1 + DEC_B;
constexpr int NH = 32, QLORA = 1024, KVLORA = 512, ROPE_M = 64, NKV = 8;
constexpr float EPS = 1e-6f;
constexpr float LOG2E = 1.4426950408889634f;
constexpr float C_MLA = 0.07216878364870322f * LOG2E;
constexpr float C_DSA = 0.08838834764831845f * LOG2E;
constexpr float IDX_W_SCALE = 0.17677669529663687f;

enum { I_XP = 0, I_XS, I_CP, I_CS, I_CCKV, I_CKROPE, I_CK, I_CV, I_CKI, I_WADA, I_BADA, I_G1, I_WIN, I_GQ, I_WUQ, I_GKV, I_WUK, I_WUV, I_WOUT, I_G2, I_WUP, I_WDOWN, I_GF, N_IN };
constexpr size_t O_Y = 0, O_CKV_P = 34603008, O_KROPE_P = 38797312, O_K_P = 39321600, O_V_P = 47710208, O_KI_P = 56098816,
                 O_CKV_S = 57147392, O_KROPE_S = 57278464, O_K_S = 57294848, O_V_S = 57556992, O_KI_S = 57819136, O_END = 57851904;

constexpr size_t MiB = 1u << 20;
constexpr size_t WS_CTL = 0, CTL_ZERO_BYTES = 4 * MiB;
constexpr size_t WS_ADA = 1 * MiB;
constexpr size_t WS_ROPE = 4 * MiB;
constexpr size_t WS_WI = 7 * MiB;
constexpr size_t WS_MASK = 9 * MiB;
constexpr size_t WS_WOUT = 18 * MiB, WS_WUP = 50 * MiB, WS_WDOWN = 178 * MiB, WS_WIN = 306 * MiB, WS_WUQ = 464 * MiB, WS_WUKV = 476 * MiB;
constexpr size_t WS_QN = WS_WIN, WS_QAN = WS_WIN + 17 * MiB, WS_QAR = WS_WIN + 83 * MiB;
constexpr size_t WS_XN = 484 * MiB;
constexpr size_t WS_CKV = 550 * MiB, WS_KROPE = 575 * MiB, WS_KALL = 579 * MiB, WS_VALL = 629 * MiB, WS_KI = 679 * MiB;
constexpr size_t WS_QB = 686 * MiB, WS_QI = 752 * MiB, WS_SGA = 818 * MiB, WS_SGB = 884 * MiB;
constexpr size_t WS_MERGED = WS_QI;
constexpr size_t WS_KN = 950 * MiB, WS_VM = 1150 * MiB;
constexpr size_t WS_U = WS_KN;
constexpr size_t WS_SLAB = WS_VM + 64 * MiB;
constexpr int SPLIT_OUT = 8, SPLIT_DOWN = 16;
constexpr size_t WS_OUTA = 1350 * MiB;
constexpr size_t WS_QRAW = 1416 * MiB, WS_CKVRAW = 1449 * MiB;
constexpr size_t WS_SCORE = WS_QRAW;
__host__ __device__ constexpr int score_pitch(int c) { return c < 16 ? 1024 : c < 32 ? 2048 : c < 64 ? 4096 : 8192; }
__host__ __device__ constexpr size_t score_chunk_off(int c) { return c < 16 ? (size_t)c * 65536 : c < 32 ? (size_t)1048576 + (size_t)(c - 16) * 131072 : c < 64 ? (size_t)3145728 + (size_t)(c - 32) * 262144 : (size_t)11534336 + (size_t)(c - 64) * 524288; }
constexpr size_t SCORE_P_FLOATS = score_chunk_off(128);
constexpr int SPITCH_SC = 2048;
constexpr size_t WS_END = WS_SCORE + (SCORE_P_FLOATS + (size_t)NSAMP * SPITCH_SC) * 4;
static_assert(WS_WIN + (size_t)DINP * DM * 2 <= WS_WUQ && WS_QAR + (size_t)NROW * 2048 * 2 <= WS_WUQ, "ws map 1");
static_assert(WS_KN + (size_t)KROWS * 4096 * 2 <= WS_VM && WS_VM + (size_t)KROWS * 4096 * 2 <= WS_OUTA && WS_U + (size_t)NROW * DFF * 2 <= WS_OUTA, "ws map 2");
static_assert(WS_MASK + (size_t)NROW * 128 * 8 <= WS_WOUT && WS_ADA + (size_t)NVEC * NADA * 4 <= CTL_ZERO_BYTES, "ws map 3");
constexpr int CW_TMO = 0, CW_BAR = 4096;

constexpr int RING_BYTES = 131072;
constexpr int LDSCTL_OFF = RING_BYTES, MISC_OFF = LDSCTL_OFF + 320;
constexpr int LDS_BYTES = 147456;

#define GAS __attribute__((address_space(1)))
#define LAS __attribute__((address_space(3)))
typedef unsigned short bf16;
typedef unsigned v4u __attribute__((ext_vector_type(4)));
typedef unsigned v2u __attribute__((ext_vector_type(2)));
typedef float v4f __attribute__((ext_vector_type(4)));
typedef GAS unsigned gu32;
#define RLX_AGENT __ATOMIC_RELAXED, __HIP_MEMORY_SCOPE_AGENT
#define LDS_WAIT() asm volatile("s_waitcnt lgkmcnt(0)" ::: "memory")
#define VM_WAIT() asm volatile("s_waitcnt vmcnt(0)" ::: "memory")
__device__ __forceinline__ unsigned f2bf(float f) { unsigned u = __builtin_bit_cast(unsigned, f); return (u + 0x7fffu + ((u >> 16) & 1u)) >> 16; }
__device__ __forceinline__ unsigned pk2(float lo, float hi) { return f2bf(lo) | (f2bf(hi) << 16); }
__device__ __forceinline__ float bf2f(unsigned short b) { return __builtin_bit_cast(float, (unsigned)b << 16); }
__device__ __forceinline__ float wave_sum(float v) {
#pragma unroll
    for (int o = 1; o < 64; o <<= 1) v += __shfl_xor(v, o);
    return v;
}
__device__ __forceinline__ int row_vec(int r) { return r < SEQ ? 0 : 1 + ((r - SEQ) >> 4); }
__device__ __forceinline__ int row_key(int r) { return r < SEQ ? r : SEQ + ((r - SEQ) >> 4) * SPITCH + PAST + (r & 15); }
__device__ __forceinline__ int row_pos(int r) { return r < SEQ ? r : PAST + (r & 15); }

namespace pg8 {
#define PG8_LAS __attribute__((address_space(3)))
typedef unsigned short bf16_t;
typedef short bf16x8 __attribute__((ext_vector_type(8)));
typedef float f32x4 __attribute__((ext_vector_type(4)));
typedef unsigned u32x4 __attribute__((ext_vector_type(4)));
constexpr int BM = 256, BK = 64, HALF = 128, HTB = HALF * BK * 2  , STAGE_BYTES = 8 * HTB, NXCD = 8, WGM = 8;

__host__ __device__ __forceinline__ int lds_byte(int r, int c) { const int st = (r >> 4) * 2 + (c >> 5), rr = r & 15, cc = c & 31, ob = rr * 64 + cc * 2; return st * 1024 + (ob ^ (((ob >> 9) & 1) << 5)); }
__host__ __device__ __forceinline__ void stage_rc(int b, int& R, int& C) { const int st = b / 1024, sb = b % 1024, swz = sb ^ (((sb >> 9) & 1) << 5); R = (st >> 1) * 16 + swz / 64; C = (st & 1) * 32 + (swz % 64) / 2; }
__host__ __device__ __forceinline__ int perm32(int rho) { const int n = rho >> 4, i = rho & 15; return 8 * (i >> 2) + 4 * n + (i & 3); }

struct Unit { int pm, pn, k0, nt, sp, hf; };
struct Gemm { const bf16_t* A; const bf16_t* Bt; int M, N, K; };

struct StaticOrder {
    int nM, nN, nwg, G, c, lim;
    __host__ __device__ void init(int M, int N, int G_, int c_) { nM = M / BM; nN = N / BM; nwg = nM * nN; G = G_; c = c_; lim = nwg; }
    __host__ __device__ __forceinline__ bool next(int i, Unit& u) const {
        const long L = (long)i * G + c; if (L >= lim) return false;
        int wgid = (int)L; { const int q = nwg / NXCD, r = nwg % NXCD, xcd = wgid % NXCD, off = wgid / NXCD; wgid = (xcd < r ? xcd * (q + 1) : r * (q + 1) + (xcd - r) * q) + off; }
        const int nig = WGM * nN, gid = wgid / nig, fm = gid * WGM, gsz = (nM - fm) < WGM ? (nM - fm) : WGM;
        u.pm = fm + ((wgid % nig) % gsz); u.pn = (wgid % nig) / gsz; u.k0 = 0; u.nt = 0; u.sp = -1; u.hf = 0; return true;
    }
    __device__ __forceinline__ void a_ready(const Unit&) const {}
    __device__ __forceinline__ void done(const Unit&) const {}
};

struct TailHalfOrder {
    int nM, nN, nwg, G, c, nfull;
    __host__ __device__ void init(int M, int N, int G_, int c_) { nM = M / BM; nN = N / BM; nwg = nM * nN; G = G_; c = c_; nfull = (nwg / G) * G; }
    __host__ __device__ __forceinline__ bool next(int i, Unit& u) const {
        const long s_ = (long)i * G + c; if (s_ >= 2L * (nwg - nfull)) return false;
        int wgid = nfull + (int)(s_ >> 1); { const int q = nwg / NXCD, r = nwg % NXCD, xcd = wgid % NXCD, off = wgid / NXCD; wgid = (xcd < r ? xcd * (q + 1) : r * (q + 1) + (xcd - r) * q) + off; }
        const int nig = WGM * nN, gid = wgid / nig, fm = gid * WGM, gsz = (nM - fm) < WGM ? (nM - fm) : WGM;
        u.pm = fm + ((wgid % nig) % gsz); u.pn = (wgid % nig) / gsz; u.k0 = 0; u.nt = 0; u.sp = -1; u.hf = (int)(s_ & 1); return true;
    }
    __device__ __forceinline__ void a_ready(const Unit&) const {}
    __device__ __forceinline__ void done(const Unit&) const {}
};

struct SampleSplitOrder {
    int nMp, nN, nwg, S, ntk, G, c;
    __host__ __device__ void init(int Mp, int N, int K, int S_, int G_, int c_) { nMp = Mp / BM; nN = N / BM; nwg = nMp * nN; S = S_; ntk = K / BK; G = G_; c = c_; }
    __host__ __device__ __forceinline__ bool next(int i, Unit& u) const {
        const long L = (long)i * G + c; int pm, pn, k0 = 0, nt = 0, sp = -1; bool ok = true;
        if (L < nwg) {
            int wgid = (int)L; { const int q = nwg / NXCD, r = nwg % NXCD, xcd = wgid % NXCD, off = wgid / NXCD; wgid = (xcd < r ? xcd * (q + 1) : r * (q + 1) + (xcd - r) * q) + off; }
            const int nig = WGM * nN, gid = wgid / nig, fm = gid * WGM, gsz = (nMp - fm) < WGM ? (nMp - fm) : WGM;
            pm = fm + ((wgid % nig) % gsz); pn = (wgid % nig) / gsz;
        } else {
            const int s = (int)(L - nwg); ok = s < nN * S; sp = s / nN; pn = s - sp * nN; pm = nMp; nt = ntk / S; k0 = sp * nt * BK;
        }
        u.pm = pm; u.pn = pn; u.k0 = k0; u.nt = nt; u.sp = sp; u.hf = 0; return ok;
    }
    __device__ __forceinline__ void a_ready(const Unit&) const {}
    __device__ __forceinline__ void done(const Unit&) const {}
};
typedef float cvt_f32x2_t __attribute__((ext_vector_type(2))); typedef __bf16 cvt_bf16x2_t __attribute__((ext_vector_type(2)));
__device__ __forceinline__ unsigned cvt_pk_bf16(float lo, float hi) { cvt_f32x2_t v = {lo, hi}; cvt_bf16x2_t b = __builtin_convertvector(v, cvt_bf16x2_t); return __builtin_bit_cast(unsigned, b); }

typedef float f32x2 __attribute__((ext_vector_type(2)));
typedef unsigned u32x2 __attribute__((ext_vector_type(2)));
__device__ __forceinline__ u32x2 pack4(f32x4 v) { u32x2 w; w.x = cvt_pk_bf16(v[0], v[1]); w.y = cvt_pk_bf16(v[2], v[3]); return w; }
__device__ __forceinline__ void rope4(f32x4& x1, f32x4& x2, const f32x4 c, const f32x4 s) { const f32x4 a = x1 * c - x2 * s, b = x2 * c + x1 * s; x1 = a; x2 = b; }
__device__ __forceinline__ f32x4 sigmoid4(f32x4 v) { f32x4 o;
#pragma unroll
    for (int e = 0; e < 4; ++e) o[e] = __builtin_amdgcn_rcpf(1.0f + __builtin_amdgcn_exp2f(-1.4426950408889634f * v[e]));
    return o; }

struct RowStage {
    PG8_LAS unsigned char* grp; unsigned roff0, roff1;
    __device__ __forceinline__ void init(PG8_LAS unsigned char* stg, int wr, int wc, int lane) {
        grp = stg + wr * 8192; const int rr0 = 4 * wc + (lane >> 5), c = lane & 31;
        roff0 = (unsigned)rr0 * 512u + ((unsigned)((c & 16) | ((c ^ rr0) & 15)) << 4); roff1 = (unsigned)(rr0 + 2) * 512u + ((unsigned)((c & 16) | ((c ^ (rr0 + 2)) & 15)) << 4);
    }
    static __device__ __forceinline__ unsigned woff(int fr, int ch8) { const int c16 = ch8 >> 1; return (unsigned)fr * 512u + ((unsigned)((c16 & 16) | ((c16 ^ fr) & 15)) << 4) + (unsigned)(ch8 & 1) * 8u; }
    __device__ __forceinline__ void step(bool first, const unsigned (&wo)[4], const u32x2 (&p)[4], bf16_t* o, size_t ldc) const {
        if (!first) __builtin_amdgcn_s_barrier();
#pragma unroll
        for (int k = 0; k < 4; ++k) *(PG8_LAS u32x2*)(grp + wo[k]) = p[k];
        asm volatile("s_waitcnt lgkmcnt(0)" ::: "memory"); __builtin_amdgcn_s_barrier();
        const u32x4 r0 = *(const PG8_LAS u32x4*)(grp + roff0), r1 = *(const PG8_LAS u32x4*)(grp + roff1);
        asm volatile("s_waitcnt lgkmcnt(0)" ::: "memory");
        *(u32x4*)o = r0; *(u32x4*)(o + 2 * ldc) = r1;
    }
};

template <int ACT> struct EpiBf16 {
    static constexpr bool PERM = true, AFTER_DRAIN = false, STAGED = true;
    bf16_t* O; int ldc; int split_cols; size_t split_stride;
    template <bool HU> __device__ __forceinline__ void run(const f32x4 (&acc)[2][2][4][2], const Unit& u, int wr, int wc, int fr, int fq) const {
        const int row0 = u.pm * BM + wr * 64 + fr; int colt = u.pn * BM; bf16_t* base = O;
        if (split_cols) { const int t = colt / split_cols; base += (size_t)t * split_stride; colt -= t * split_cols; }
        const int col0 = colt + wc * 32 + 8 * fq;
#pragma unroll
        for (int ai = 0; ai < 2; ++ai)
#pragma unroll
            for (int m = 0; m < 4; ++m) { bf16_t* rowp = base + (size_t)(row0 + ai * HALF + m * 16) * ldc + col0;
#pragma unroll
                for (int bj = 0; bj < 2; ++bj) { f32x4 v0 = acc[ai][bj][m][0], v1 = acc[ai][bj][m][1];
                    if (ACT == 2) {
#pragma unroll
                        for (int e = 0; e < 4; ++e) { const float a = __builtin_amdgcn_fmed3f(v0[e], 0.f, 3.0e38f), b = __builtin_amdgcn_fmed3f(v1[e], 0.f, 3.0e38f); v0[e] = a * a; v1[e] = b * b; } }
                    u32x4 w; w.x = cvt_pk_bf16(v0[0], v0[1]); w.y = cvt_pk_bf16(v0[2], v0[3]); w.z = cvt_pk_bf16(v1[0], v1[1]); w.w = cvt_pk_bf16(v1[2], v1[3]);
                    *(u32x4*)(rowp + bj * HALF) = w; } }
    }
    template <bool HU> __device__ __forceinline__ void staged(const f32x4 (&acc)[2][2][4][2], const Unit& u, int wr, int wc, int fr, int fq, PG8_LAS unsigned char* stg, int lane) const {
        int colt = u.pn * BM; bf16_t* base = O;
        if (split_cols) { const int t = colt / split_cols; base += (size_t)t * split_stride; colt -= t * split_cols; }
        PG8_LAS unsigned char* grp = stg + wr * 8192;
        const unsigned woff = (unsigned)fr * 512u + ((((unsigned)(4 * wc + fq)) ^ (unsigned)fr) << 4);
        const int rr0 = 4 * wc + (lane >> 5), c = lane & 31;
        const unsigned roff0 = (unsigned)rr0 * 512u + ((unsigned)((c & 16) | ((c ^ rr0) & 15)) << 4), roff1 = (unsigned)(rr0 + 2) * 512u + ((unsigned)((c & 16) | ((c ^ (rr0 + 2)) & 15)) << 4);
        bf16_t* gp = base + (size_t)(u.pm * BM + (HU && u.hf ? HALF : 0) + wr * 64 + rr0) * ldc + colt + c * 8;
#pragma unroll
        for (int ai = 0; ai < (HU ? 1 : 2); ++ai)
#pragma unroll
            for (int m = 0; m < 4; ++m) {
                u32x4 w[2];
#pragma unroll
                for (int bj = 0; bj < 2; ++bj) { f32x4 v0 = acc[ai][bj][m][0], v1 = acc[ai][bj][m][1];
                    if (ACT == 2) {
#pragma unroll
                        for (int e = 0; e < 4; ++e) { const float a = __builtin_amdgcn_fmed3f(v0[e], 0.f, 3.0e38f), b = __builtin_amdgcn_fmed3f(v1[e], 0.f, 3.0e38f); v0[e] = a * a; v1[e] = b * b; } }
                    w[bj].x = cvt_pk_bf16(v0[0], v0[1]); w[bj].y = cvt_pk_bf16(v0[2], v0[3]); w[bj].z = cvt_pk_bf16(v1[0], v1[1]); w[bj].w = cvt_pk_bf16(v1[2], v1[3]); }
                if (ai | m) __builtin_amdgcn_s_barrier();
                *(PG8_LAS u32x4*)(grp + woff) = w[0]; *(PG8_LAS u32x4*)(grp + woff + 256) = w[1];
                asm volatile("s_waitcnt lgkmcnt(0)" ::: "memory"); __builtin_amdgcn_s_barrier();
                const u32x4 r0 = *(const PG8_LAS u32x4*)(grp + roff0), r1 = *(const PG8_LAS u32x4*)(grp + roff1);
                asm volatile("s_waitcnt lgkmcnt(0)" ::: "memory");
                bf16_t* o = gp + (size_t)(ai * HALF + m * 16) * ldc;
                *(u32x4*)o = r0; *(u32x4*)(o + (size_t)2 * ldc) = r1;
            }
        __builtin_amdgcn_s_barrier();
    }
};

struct EpiIn {
    static constexpr bool PERM = false, AFTER_DRAIN = false, STAGED = true;
    float* qraw; float* ckvraw; bf16_t* qb; bf16_t* qi; bf16_t* sga; bf16_t* sgb;
    bf16_t* kall; bf16_t* vall; bf16_t* kiall; bf16_t* kropeall; float* wi; float* out;
    const float* cos_m; const float* sin_m; const float* cos_d; const float* sin_d;
    template <bool HU> __device__ __forceinline__ void run(const f32x4 (&acc)[2][2][4][2], const Unit& u, int wr, int wc, int fr, int fq) const {
        const int pn = u.pn; const bool samp = (u.pm == SEQ / BM); const int rb = u.pm * BM + (HU && u.hf ? HALF : 0);
#pragma unroll
        for (int ai = 0; ai < (HU ? 1 : 2); ++ai)
#pragma unroll
            for (int m = 0; m < 4; ++m) {
                const int r = rb + ai * HALF + wr * 64 + m * 16 + fr;
                const int ro = samp ? r - SEQ : r;
                const int kr = row_key(r), pos = row_pos(r);
                if (pn < 4) {
#pragma unroll
                    for (int bj = 0; bj < 2; ++bj)
#pragma unroll
                        for (int n = 0; n < 2; ++n) *(f32x4*)(qraw + (size_t)r * QLORA + pn * BM + bj * HALF + wc * 32 + n * 16 + 4 * fq) = acc[ai][bj][m][n];
                } else if (pn < 6) {
#pragma unroll
                    for (int bj = 0; bj < 2; ++bj)
#pragma unroll
                        for (int n = 0; n < 2; ++n) *(f32x4*)(ckvraw + (size_t)r * KVLORA + (pn - 4) * BM + bj * HALF + wc * 32 + n * 16 + 4 * fq) = acc[ai][bj][m][n];
                } else if (pn < 78) {
                    const int kind = pn < 22 ? 0 : pn < 26 ? 1 : pn < 30 ? 2 : pn < 46 ? 3 : pn < 62 ? 4 : 5;
                    const int t0 = kind == 0 ? 6 : kind == 1 ? 22 : kind == 2 ? 26 : kind == 3 ? 30 : kind == 4 ? 46 : 62;
                    const bool roped = (kind == 0 || kind == 1 || kind == 3);
                    f32x4 cs = {0.f, 0.f, 0.f, 0.f}, sn = cs;
                    if (roped && wc == 0) { cs = *(const f32x4*)(cos_d + pos * 16 + 4 * fq); sn = *(const f32x4*)(sin_d + pos * 16 + 4 * fq); }
#pragma unroll
                    for (int bj = 0; bj < 2; ++bj) {
                        f32x4 v0 = acc[ai][bj][m][0], v1 = acc[ai][bj][m][1];
                        if (roped && wc == 0) rope4(v0, v1, cs, sn);
                        const int c0 = (pn - t0) * BM + bj * HALF + wc * 32 + 4 * fq;
                        if (kind == 0) { *(u32x2*)(qb + (size_t)r * DM + c0) = pack4(v0 * C_DSA); *(u32x2*)(qb + (size_t)r * DM + c0 + 16) = pack4(v1 * C_DSA); }
                        else if (kind == 3) { *(u32x2*)(qi + (size_t)r * DM + c0) = pack4(v0); *(u32x2*)(qi + (size_t)r * DM + c0 + 16) = pack4(v1); }
                        else if (kind == 4) { *(u32x2*)(sga + (size_t)r * DM + c0) = pack4(sigmoid4(v0)); *(u32x2*)(sga + (size_t)r * DM + c0 + 16) = pack4(sigmoid4(v1)); }
                        else if (kind == 5) { *(u32x2*)(sgb + (size_t)r * DM + c0) = pack4(sigmoid4(v0)); *(u32x2*)(sgb + (size_t)r * DM + c0 + 16) = pack4(sigmoid4(v1)); }
                        else {
                            float* o = out + (kind == 1 ? (samp ? O_K_S : O_K_P) : (samp ? O_V_S : O_V_P)) + (size_t)ro * 1024 + c0;
                            *(f32x4*)o = v0; *(f32x4*)(o + 16) = v1;
                            bf16_t* kb = (kind == 1 ? kall : vall) + (size_t)kr * 1024 + c0;
                            *(u32x2*)kb = pack4(v0); *(u32x2*)(kb + 16) = pack4(v1);
                        }
                    }
                } else {
                    {
                        f32x4 v0 = acc[ai][0][m][0], v1 = acc[ai][0][m][1];
                        if (wc < 2) {
                            const f32x4 cs = *(const f32x4*)(cos_m + pos * 32 + 16 * wc + 4 * fq), sn = *(const f32x4*)(sin_m + pos * 32 + 16 * wc + 4 * fq);
                            rope4(v0, v1, cs, sn);
                            float* o = out + (samp ? O_KROPE_S : O_KROPE_P) + (size_t)ro * 64 + 16 * wc + 4 * fq;
                            *(f32x4*)o = v0; *(f32x4*)(o + 32) = v1;
                            bf16_t* kb = kropeall + (size_t)kr * 64 + 16 * wc + 4 * fq;
                            *(u32x2*)kb = pack4(v0); *(u32x2*)(kb + 32) = pack4(v1);
                        } else if (wc == 2) {
                            *(f32x4*)(wi + (size_t)r * 32 + 4 * fq) = v0 * IDX_W_SCALE; *(f32x4*)(wi + (size_t)r * 32 + 16 + 4 * fq) = v1 * IDX_W_SCALE;
                        }
                    }
                    {
                        f32x4 v0 = acc[ai][1][m][0], v1 = acc[ai][1][m][1];
                        if (wc == 0) { const f32x4 cs = *(const f32x4*)(cos_d + pos * 16 + 4 * fq), sn = *(const f32x4*)(sin_d + pos * 16 + 4 * fq); rope4(v0, v1, cs, sn); }
                        const int c0 = wc * 32 + 4 * fq;
                        float* o = out + (samp ? O_KI_S : O_KI_P) + (size_t)ro * 128 + c0;
                        *(f32x4*)o = v0; *(f32x4*)(o + 16) = v1;
                        bf16_t* kb = kiall + (size_t)kr * 128 + c0;
                        *(u32x2*)kb = pack4(v0); *(u32x2*)(kb + 16) = pack4(v1);
                    }
                }
            }
    }
    template <bool HU> __device__ __forceinline__ void staged(const f32x4 (&acc)[2][2][4][2], const Unit& u, int wr, int wc, int fr, int fq, PG8_LAS unsigned char* stg, int lane) const {
        const int pn = u.pn;
        const int kind = pn < 22 ? 0 : pn < 26 ? 1 : pn < 30 ? 2 : pn < 46 ? 3 : pn < 62 ? 4 : 5;
        if (pn < 6 || pn >= 78 || kind == 1 || kind == 2) { this->template run<HU>(acc, u, wr, wc, fr, fq); return; }
        const int t0 = kind == 0 ? 6 : kind == 3 ? 30 : kind == 4 ? 46 : 62;
        const bool roped = (kind == 0 || kind == 3);
        bf16_t* const d0 = qb; bf16_t* const d3 = qi; bf16_t* const d4 = sga; bf16_t* const d5 = sgb;
        bf16_t* dst = kind == 0 ? d0 : kind == 3 ? d3 : kind == 4 ? d4 : d5;
        RowStage R; R.init(stg, wr, wc, lane);
        unsigned wo[4];
#pragma unroll
        for (int k = 0; k < 4; ++k) wo[k] = RowStage::woff(fr, 32 * (k >> 1) + 8 * wc + 4 * (k & 1) + fq);
        const int rb = u.pm * BM + (HU && u.hf ? HALF : 0);
        bf16_t* gp = dst + (size_t)(rb + wr * 64 + 4 * wc + (lane >> 5)) * DM + (pn - t0) * BM + (lane & 31) * 8;
#pragma unroll
        for (int ai = 0; ai < (HU ? 1 : 2); ++ai)
#pragma unroll
            for (int m = 0; m < 4; ++m) {
                const int r = rb + ai * HALF + wr * 64 + m * 16 + fr, pos = row_pos(r);
                f32x4 cs = {0.f, 0.f, 0.f, 0.f}, sn = cs;
                if (roped && wc == 0) { cs = *(const f32x4*)(cos_d + pos * 16 + 4 * fq); sn = *(const f32x4*)(sin_d + pos * 16 + 4 * fq); }
                u32x2 p[4];
#pragma unroll
                for (int bj = 0; bj < 2; ++bj) {
                    f32x4 v0 = acc[ai][bj][m][0], v1 = acc[ai][bj][m][1];
                    if (roped && wc == 0) rope4(v0, v1, cs, sn);
                    if (kind == 0) { p[2 * bj] = pack4(v0 * C_DSA); p[2 * bj + 1] = pack4(v1 * C_DSA); }
                    else if (kind == 3) { p[2 * bj] = pack4(v0); p[2 * bj + 1] = pack4(v1); }
                    else { p[2 * bj] = pack4(sigmoid4(v0)); p[2 * bj + 1] = pack4(sigmoid4(v1)); }
                }
                R.step((ai | m) == 0, wo, p, gp + (size_t)(ai * HALF + m * 16) * DM, DM);
            }
        __builtin_amdgcn_s_barrier();
    }
};

struct EpiUq {
    static constexpr bool PERM = false, AFTER_DRAIN = false, STAGED = true;
    bf16_t* qan; bf16_t* qar; const float* cos_m; const float* sin_m;
    template <bool HU> __device__ __forceinline__ void run(const f32x4 (&acc)[2][2][4][2], const Unit& u, int wr, int wc, int fr, int fq) const {
        const int pn = u.pn;
#pragma unroll
        for (int ai = 0; ai < 2; ++ai)
#pragma unroll
            for (int m = 0; m < 4; ++m) {
                const int r = u.pm * BM + ai * HALF + wr * 64 + m * 16 + fr;
                if (pn < 16) {
#pragma unroll
                    for (int bj = 0; bj < 2; ++bj)
#pragma unroll
                        for (int n = 0; n < 2; ++n) *(u32x2*)(qan + (size_t)r * 4096 + pn * BM + bj * HALF + wc * 32 + n * 16 + 4 * fq) = pack4(acc[ai][bj][m][n] * C_MLA);
                } else {
                    const int pos = row_pos(r), w = wc & 1;
                    const f32x4 cs = *(const f32x4*)(cos_m + pos * 32 + 16 * w + 4 * fq), sn = *(const f32x4*)(sin_m + pos * 32 + 16 * w + 4 * fq);
#pragma unroll
                    for (int bj = 0; bj < 2; ++bj) {
                        const int head = ((pn - 16) * 2 + bj) * 2 + (wc >> 1);
                        f32x4 v0 = acc[ai][bj][m][0], v1 = acc[ai][bj][m][1];
                        rope4(v0, v1, cs, sn);
                        bf16_t* o = qar + (size_t)r * 2048 + head * 64 + 16 * w + 4 * fq;
                        *(u32x2*)o = pack4(v0 * C_MLA); *(u32x2*)(o + 32) = pack4(v1 * C_MLA);
                    }
                }
            }
    }
    template <bool HU> __device__ __forceinline__ void staged(const f32x4 (&acc)[2][2][4][2], const Unit& u, int wr, int wc, int fr, int fq, PG8_LAS unsigned char* stg, int lane) const {
        const int pn = u.pn; const bool rp = pn >= 16; const int w = wc & 1;
        RowStage R; R.init(stg, wr, wc, lane);
        unsigned wo[4];
#pragma unroll
        for (int k = 0; k < 4; ++k) wo[k] = RowStage::woff(fr, rp ? 16 * (2 * (k >> 1) + (wc >> 1)) + 8 * (k & 1) + 4 * w + fq : 32 * (k >> 1) + 8 * wc + 4 * (k & 1) + fq);
        const size_t ldo = rp ? 2048 : 4096;
        bf16_t* const e0 = qar; bf16_t* const e1 = qan;
        bf16_t* gp = (rp ? e0 + (pn - 16) * BM : e1 + pn * BM) + (size_t)(u.pm * BM + wr * 64 + 4 * wc + (lane >> 5)) * ldo + (lane & 31) * 8;
#pragma unroll
        for (int ai = 0; ai < 2; ++ai)
#pragma unroll
            for (int m = 0; m < 4; ++m) {
                const int r = u.pm * BM + ai * HALF + wr * 64 + m * 16 + fr, pos = row_pos(r);
                f32x4 cs = {0.f, 0.f, 0.f, 0.f}, sn = cs;
                if (rp) { cs = *(const f32x4*)(cos_m + pos * 32 + 16 * w + 4 * fq); sn = *(const f32x4*)(sin_m + pos * 32 + 16 * w + 4 * fq); }
                u32x2 p[4];
#pragma unroll
                for (int bj = 0; bj < 2; ++bj) {
                    f32x4 v0 = acc[ai][bj][m][0], v1 = acc[ai][bj][m][1];
                    if (rp) rope4(v0, v1, cs, sn);
                    p[2 * bj] = pack4(v0 * C_MLA); p[2 * bj + 1] = pack4(v1 * C_MLA);
                }
                R.step((ai | m) == 0, wo, p, gp + (size_t)(ai * HALF + m * 16) * ldo, ldo);
            }
        __builtin_amdgcn_s_barrier();
    }
};

struct EpiRes {
    static constexpr bool PERM = false, AFTER_DRAIN = false, STAGED = false;
    const float* xp; const float* xs; float* y; const float* gate; float* slab;
    template <bool HU> __device__ __forceinline__ void run(const f32x4 (&acc)[2][2][4][2], const Unit& u, int wr, int wc, int fr, int fq) const {
        const int col0 = u.pn * BM + wc * 32 + 4 * fq;
        if (u.sp >= 0) {
#pragma unroll
            for (int ai = 0; ai < 2; ++ai)
#pragma unroll
                for (int m = 0; m < 4; ++m) { float* o = slab + ((size_t)u.sp * BM + ai * HALF + wr * 64 + m * 16 + fr) * DM + col0;
#pragma unroll
                    for (int bj = 0; bj < 2; ++bj)
#pragma unroll
                        for (int n = 0; n < 2; ++n) *(f32x4*)(o + bj * HALF + n * 16) = acc[ai][bj][m][n]; }
            return;
        }
#pragma unroll
        for (int ai = 0; ai < 2; ++ai)
#pragma unroll
            for (int m = 0; m < 4; ++m) {
                const int r = u.pm * BM + ai * HALF + wr * 64 + m * 16 + fr;
                const float* b = (r < SEQ ? xp + (size_t)r * DM : xs + (size_t)(r - SEQ) * DM) + col0;
                const float* g = gate + (size_t)row_vec(r) * NADA + col0;
                float* o = y + (size_t)r * DM + col0;
#pragma unroll
                for (int bj = 0; bj < 2; ++bj)
#pragma unroll
                    for (int n = 0; n < 2; ++n) { const int c = bj * HALF + n * 16; *(f32x4*)(o + c) = *(const f32x4*)(b + c) + *(const f32x4*)(g + c) * acc[ai][bj][m][n]; }
            }
    }
};
template <class Epi, class Sched, bool ALIGN_EPI = false, bool SP2 = false, bool HALFU = false>
__device__ __forceinline__ void gemm_phase(PG8_LAS unsigned char* lds, const Gemm g, const Sched& S, const Epi& E) {
    const int tid = threadIdx.x, wid = __builtin_amdgcn_readfirstlane(tid >> 6), lane = tid & 63, wr = wid >> 2, wc = wid & 3, fr = lane & 15, fq = lane >> 4;
    const int K = g.K, nt_full = K / BK;
    unsigned voffA[2], voffB[2];
#pragma unroll
    for (int i = 0; i < 2; ++i) { int R, C; stage_rc(tid * 16 + i * 8192, R, C); const int Rb = Epi::PERM ? ((R & ~31) + perm32(R & 31)) : R;
        voffA[i] = (unsigned)(R * K + C) * 2u; voffB[i] = (unsigned)(Rb * K + C) * 2u; }
    const size_t kstep = (size_t)(BK * 2);
    const size_t hstep = (size_t)HALF * K * 2;
    const size_t tstep = 2 * hstep;
    const unsigned ldsw = (unsigned)wid * 1024u;
    const int aoff = lds_byte(wr * 64 + fr, fq * 8), boff = lds_byte(wc * 32 + fr, fq * 8);
#define PG8_SA(b, h) (((b) * 2 + (h)) * HTB)
#define PG8_SB(b, h) ((4 + (b) * 2 + (h)) * HTB)
#define PG8_STAGE(bufoff, gbase, voff) do { _Pragma("unroll") for (int _i = 0; _i < 2; ++_i) \
        __builtin_amdgcn_global_load_lds((const unsigned*)((const char*)(gbase) + (voff)[_i]), (PG8_LAS unsigned*)(lds + (bufoff) + ldsw + _i * 8192), 16, 0, 0); } while (0)
#define PG8_LDA(dst, b, h) do { _Pragma("unroll") for (int m = 0; m < 4; ++m) _Pragma("unroll") for (int k = 0; k < 2; ++k) dst[m][k] = *(const PG8_LAS bf16x8*)(lds + PG8_SA(b, h) + aoff + m * 2048 + k * 1024); } while (0)
#define PG8_LDB(dst, b, h) do { _Pragma("unroll") for (int n = 0; n < 2; ++n) _Pragma("unroll") for (int k = 0; k < 2; ++k) dst[n][k] = *(const PG8_LAS bf16x8*)(lds + PG8_SB(b, h) + boff + n * 2048 + k * 1024); } while (0)
#define PG8_MMA(ai, bj, At, Bt) do { __builtin_amdgcn_s_setprio(1); _Pragma("unroll") for (int m = 0; m < 4; ++m) _Pragma("unroll") for (int n = 0; n < 2; ++n) _Pragma("unroll") for (int k = 0; k < 2; ++k) \
        acc[ai][bj][m][n] = __builtin_amdgcn_mfma_f32_16x16x32_bf16(Bt[n][k], At[m][k], acc[ai][bj][m][n], 0, 0, 0); __builtin_amdgcn_s_setprio(0); } while (0)
#define PG8_WAIT_V(n) asm volatile("s_waitcnt vmcnt(" #n ")" ::: "memory")
#define PG8_WAIT_L(n) asm volatile("s_waitcnt lgkmcnt(" #n ")" ::: "memory")
#define PG8_BAR __builtin_amdgcn_s_barrier()
#define PG8_SCHED __builtin_amdgcn_sched_barrier(0)
    Unit cur, nxt; int ui = 0;
    if (!S.next(0, cur)) return;
    f32x4 acc[2][2][4][2];
#pragma unroll
    for (int a = 0; a < 2; ++a)
#pragma unroll
        for (int b = 0; b < 2; ++b)
#pragma unroll
            for (int m = 0; m < 4; ++m)
#pragma unroll
                for (int n = 0; n < 2; ++n) acc[a][b][m][n] = (f32x4){0.f, 0.f, 0.f, 0.f};
    bf16x8 At[4][2], B0[2][2], B1[2][2];
    const char* cA = (const char*)g.A + (size_t)cur.pm * tstep + (HALFU && cur.hf ? hstep : (size_t)0) + (size_t)cur.k0 * 2; const char* cB = (const char*)g.Bt + (size_t)cur.pn * tstep + (size_t)cur.k0 * 2;
    S.a_ready(cur);
    if constexpr (SP2) {
        PG8_STAGE(PG8_SB(0, 0), cB, voffB); PG8_STAGE(PG8_SB(0, 1), cB + hstep, voffB); PG8_STAGE(PG8_SA(0, 0), cA, voffA); PG8_STAGE(PG8_SA(0, 1), cA + hstep, voffA);
        if (wr == 1) PG8_BAR;
        PG8_WAIT_V(2); PG8_BAR;
        PG8_STAGE(PG8_SB(1, 0), cB + kstep, voffB); PG8_STAGE(PG8_SA(1, 0), cA + kstep, voffA); PG8_STAGE(PG8_SB(1, 1), cB + hstep + kstep, voffB);
        PG8_WAIT_V(6); PG8_BAR;
    } else {
        PG8_STAGE(PG8_SB(0, 0), cB, voffB); PG8_STAGE(PG8_SA(0, 0), cA, voffA); PG8_STAGE(PG8_SB(0, 1), cB + hstep, voffB); PG8_STAGE(PG8_SA(0, 1), cA + hstep, voffA);
        if (wr == 1) PG8_BAR;
        PG8_WAIT_V(4); PG8_BAR;
        PG8_STAGE(PG8_SB(1, 0), cB + kstep, voffB); PG8_STAGE(PG8_SA(1, 0), cA + kstep, voffA); PG8_STAGE(PG8_SB(1, 1), cB + hstep + kstep, voffB);
        PG8_WAIT_V(6); PG8_BAR;
    }
    for (;;) {
        const bool has_next = S.next(ui + 1, nxt);
        const char* nA = has_next ? (const char*)g.A + (size_t)nxt.pm * tstep + (HALFU && nxt.hf ? hstep : (size_t)0) + (size_t)nxt.k0 * 2 : cA; const char* nB = has_next ? (const char*)g.Bt + (size_t)nxt.pn * tstep + (size_t)nxt.k0 * 2 : cB;
        const int nt = cur.nt ? cur.nt : nt_full;
        for (int t = 0; t < nt; t += 2) {
            const bool last = (t == nt - 2);
            const char* a1 = cA + (size_t)(t + 1) * kstep;
            const char* a2 = last ? nA : cA + (size_t)(t + 2) * kstep; const char* b2 = last ? nB : cB + (size_t)(t + 2) * kstep;
            const char* a3 = a2 + kstep; const char* b3 = b2 + kstep;
            if (last && has_next) S.a_ready(nxt);
            if constexpr (SP2) {
            PG8_LDB(B0, 0, 0); PG8_LDB(B1, 0, 1); PG8_SCHED; PG8_LDA(At, 0, 0); PG8_STAGE(PG8_SA(1, 1), a1 + hstep, voffA);
            PG8_WAIT_V(8); PG8_WAIT_L(0); PG8_BAR; PG8_MMA(0, 0, At, B0); PG8_MMA(0, 1, At, B1); PG8_BAR; PG8_SCHED;
            PG8_LDA(At, 0, 1); PG8_STAGE(PG8_SB(0, 0), b2, voffB); PG8_STAGE(PG8_SB(0, 1), b2 + hstep, voffB); PG8_STAGE(PG8_SA(0, 0), a2, voffA);
            PG8_WAIT_V(8); PG8_WAIT_L(0); PG8_BAR; if constexpr (!HALFU) { PG8_MMA(1, 0, At, B0); PG8_MMA(1, 1, At, B1); } PG8_BAR; PG8_SCHED;
            PG8_LDB(B0, 1, 0); PG8_LDB(B1, 1, 1); PG8_SCHED; PG8_LDA(At, 1, 0); PG8_STAGE(PG8_SA(0, 1), a2 + hstep, voffA);
            PG8_WAIT_V(8); PG8_WAIT_L(0); PG8_BAR; PG8_MMA(0, 0, At, B0); PG8_MMA(0, 1, At, B1); PG8_BAR; PG8_SCHED;
            PG8_LDA(At, 1, 1); PG8_STAGE(PG8_SB(1, 0), b3, voffB); PG8_STAGE(PG8_SB(1, 1), b3 + hstep, voffB); PG8_STAGE(PG8_SA(1, 0), a3, voffA);
            PG8_WAIT_V(8); PG8_WAIT_L(0); PG8_BAR; if constexpr (!HALFU) { PG8_MMA(1, 0, At, B0); PG8_MMA(1, 1, At, B1); } PG8_BAR; PG8_SCHED;
            } else {
            PG8_LDB(B0, 0, 0); PG8_SCHED; PG8_LDA(At, 0, 0); PG8_STAGE(PG8_SA(1, 1), a1 + hstep, voffA);
            PG8_WAIT_L(8); PG8_BAR; PG8_WAIT_L(0); PG8_MMA(0, 0, At, B0); PG8_BAR; PG8_SCHED;
            PG8_LDB(B1, 0, 1); PG8_STAGE(PG8_SB(0, 0), b2, voffB);
            PG8_BAR; PG8_WAIT_L(0); PG8_MMA(0, 1, At, B1); PG8_BAR;
            PG8_LDA(At, 0, 1); PG8_STAGE(PG8_SA(0, 0), a2, voffA);
            PG8_BAR; PG8_WAIT_L(0); PG8_MMA(1, 0, At, B0); PG8_BAR; PG8_SCHED;
            PG8_STAGE(PG8_SB(0, 1), b2 + hstep, voffB);
            PG8_WAIT_V(6); PG8_BAR; PG8_MMA(1, 1, At, B1); PG8_BAR;
            PG8_LDB(B0, 1, 0); PG8_SCHED; PG8_LDA(At, 1, 0); PG8_STAGE(PG8_SA(0, 1), a2 + hstep, voffA);
            PG8_WAIT_L(8); PG8_BAR; PG8_WAIT_L(0); PG8_MMA(0, 0, At, B0); PG8_BAR; PG8_SCHED;
            PG8_LDB(B1, 1, 1); PG8_STAGE(PG8_SB(1, 0), b3, voffB);
            PG8_BAR; PG8_WAIT_L(0); PG8_MMA(0, 1, At, B1); PG8_BAR;
            PG8_LDA(At, 1, 1); PG8_STAGE(PG8_SA(1, 0), a3, voffA);
            PG8_BAR; PG8_WAIT_L(0); PG8_MMA(1, 0, At, B0); PG8_BAR; PG8_SCHED;
            PG8_STAGE(PG8_SB(1, 1), b3 + hstep, voffB);
            PG8_WAIT_V(6); PG8_BAR; PG8_MMA(1, 1, At, B1); PG8_BAR;
            }
        }
        if constexpr (ALIGN_EPI) { if (wr == 0) PG8_BAR; }
        if constexpr (!Epi::AFTER_DRAIN) {
            if constexpr (Epi::STAGED) E.template staged<HALFU>(acc, cur, wr, wc, fr, fq, lds + PG8_SA(1, 1), lane);
            else E.template run<HALFU>(acc, cur, wr, wc, fr, fq);
            S.done(cur); }
        if (!has_next) break;
#pragma unroll
        for (int a = 0; a < 2; ++a)
#pragma unroll
            for (int b = 0; b < 2; ++b)
#pragma unroll
                for (int m = 0; m < 4; ++m)
#pragma unroll
                    for (int n = 0; n < 2; ++n) acc[a][b][m][n] = (f32x4){0.f, 0.f, 0.f, 0.f};
        cur = nxt; cA = nA; cB = nB; ++ui;
        if constexpr (ALIGN_EPI) { if (wr == 1) PG8_BAR; }
    }
    PG8_WAIT_V(0);
    if constexpr (!ALIGN_EPI) { if (wr == 0) PG8_BAR; }
    PG8_BAR;
    if constexpr (Epi::AFTER_DRAIN) { E.fused(acc, cur, wr, wc, fr, fq, lds, wid, lane); S.done(cur); }
#undef PG8_SA
#undef PG8_SB
#undef PG8_STAGE
#undef PG8_LDA
#undef PG8_LDB
#undef PG8_MMA
#undef PG8_WAIT_V
#undef PG8_WAIT_L
#undef PG8_BAR
#undef PG8_SCHED
}
}
#define XB_TMO      128
#define XB_XCNT(j)  (256  + 64 * (j))
#define XB_XSUB(j)  (1280 + 64 * (j))
#define XB_XGEN(j)  (2304 + 64 * (j))
#define XB_TOP      3328
#define XB_TOPGEN   3392
#define XCD_BAR_WORDS 3456
#define XB_SPIN_CAP (1u << 18)

__device__ __forceinline__ unsigned xb_ld(unsigned* p)              { return __hip_atomic_load(p, __ATOMIC_RELAXED, __HIP_MEMORY_SCOPE_AGENT); }
__device__ __forceinline__ unsigned xb_add(unsigned* p, unsigned v) { return __hip_atomic_fetch_add(p, v, __ATOMIC_RELAXED, __HIP_MEMORY_SCOPE_AGENT); }
__device__ __forceinline__ unsigned xb_xcc_id() { return (unsigned)__builtin_amdgcn_s_getreg((3 << 11) | 20) & 0xFu; }
#define XB_SPIN(cond, bar) do { unsigned _sp = 0; while (cond) { __builtin_amdgcn_s_sleep(1); \
    if ((++_sp & 255u) == 0u) { if (xb_ld(&(bar)[XB_TMO])) break; if (_sp > XB_SPIN_CAP) { atomicAdd(&(bar)[XB_TMO], 1u); break; } } } } while (0)

struct XcdBarrier {
    unsigned* bar; unsigned x;
    volatile LAS unsigned* st;
};

__device__ __forceinline__ XcdBarrier xcd_barrier_post(unsigned* bar, volatile LAS unsigned* st) {
    XcdBarrier b; b.bar = bar; b.x = xb_xcc_id(); b.st = st;
    if (threadIdx.x == 0) (void)xb_add(&bar[XB_XCNT(b.x)], 1u);
    return b;
}
__device__ __forceinline__ void xcd_barrier_complete(unsigned* bar, unsigned x, unsigned& nloc, unsigned& nx) {
    const unsigned G = gridDim.x * gridDim.y * gridDim.z;
    unsigned sum, cnt, mine, sp = 0u;
    for (;;) {
        sum = 0u; cnt = 0u; mine = 0u;
#pragma unroll
        for (unsigned j = 0; j < 16; ++j) { const unsigned c = xb_ld(&bar[XB_XCNT(j)]); sum += c; cnt += (c > 0u) ? 1u : 0u; mine = (j == x) ? c : mine; }
        if (sum == G) break;
        __builtin_amdgcn_s_sleep(1);
        if ((++sp & 255u) == 0u) { if (xb_ld(&bar[XB_TMO])) break; if (sp > XB_SPIN_CAP) { atomicAdd(&bar[XB_TMO], 1u); break; } }
    }
    nloc = mine > 0u ? mine : 1u; nx = cnt > 0u ? cnt : 1u;
}

__device__ __forceinline__ void xcd_barrier(const XcdBarrier& b) {
    asm volatile("s_waitcnt vmcnt(0)" ::: "memory");
    __syncthreads();
    if (threadIdx.x == 0) {
        unsigned* bar = b.bar;
        __builtin_amdgcn_s_waitcnt(0);
        unsigned nloc = b.st[0], nx = b.st[1];
        if (nloc == 0u) { xcd_barrier_complete(bar, b.x, nloc, nx); b.st[0] = nloc; b.st[1] = nx; }
        const unsigned old = xb_add(&bar[XB_XSUB(b.x)], 1u);
        const unsigned gen = old / nloc;
        if (old + 1u == (gen + 1u) * nloc) {
            __builtin_amdgcn_fence(__ATOMIC_RELEASE, "agent");
            asm volatile("s_waitcnt vmcnt(0)" ::: "memory");
            const unsigned og = xb_add(&bar[XB_TOP], 1u);
            const unsigned tg = og / nx;
            if (og + 1u == (tg + 1u) * nx) xb_add(&bar[XB_TOPGEN], 1u);
            else XB_SPIN(xb_ld(&bar[XB_TOPGEN]) == tg, bar);
            __builtin_amdgcn_fence(__ATOMIC_ACQUIRE, "agent");
            xb_add(&bar[XB_XGEN(b.x)], 1u);
            asm volatile("s_waitcnt vmcnt(0)" ::: "memory");
        } else {
            XB_SPIN(xb_ld(&bar[XB_XGEN(b.x)]) == gen, bar);
            __builtin_amdgcn_fence(__ATOMIC_ACQUIRE, "agent");
            asm volatile("s_waitcnt vmcnt(0)" ::: "memory");
        }
    }
    __syncthreads();
}

constexpr int NWAVES = 8;
struct Args { const float* in[N_IN]; float* out; unsigned char* ws; int ph_lo, ph_hi, li, pad; };
struct Ctx {
    LAS unsigned char* lds; const Args* a; unsigned char* ws; float* out;
    int tid, lane, wave, G, bx;
};
__device__ __forceinline__ float silu(float x) { return x / (1.0f + __expf(-x)); }

constexpr int ADA_NSPLIT = 21, ADA_NCG = NADA / 4 / 512;
constexpr int ADA_WCG = NADA / 4 / 64;
__device__ __forceinline__ void p0_wave_item(const Ctx& C, int item) {
    if (item >= ADA_WCG * ADA_NSPLIT) return;
    LAS float* sv = (LAS float*)(C.lds + C.wave * 16384);
    const float* cp = C.a->in[I_CP]; const float* cs = C.a->in[I_CS]; const float* W = C.a->in[I_WADA]; const float* B = C.a->in[I_BADA];
    float* ada = (float*)(C.ws + WS_ADA); const int lane = C.lane;
    const int cg = item % ADA_WCG, sp = item / ADA_WCG;
    const int d0 = sp * DM / ADA_NSPLIT, d1 = (sp + 1) * DM / ADA_NSPLIT, dn = d1 - d0;
    LDS_WAIT(); asm volatile("" ::: "memory");
    for (int i = lane; i < dn * NVEC; i += 64) { const int d = i / NVEC, v = i % NVEC; const float x = v == 0 ? cp[d0 + d] : cs[(size_t)(v - 1) * DM + d0 + d]; sv[d * 20 + v] = silu(x); }
    LDS_WAIT(); asm volatile("" ::: "memory");
    const int e0 = (cg * 64 + lane) * 4;
    v4f acc[NVEC];
#pragma unroll
    for (int v = 0; v < NVEC; ++v) acc[v] = (v4f){0.f, 0.f, 0.f, 0.f};
    const float* wp = W + (size_t)d0 * NADA + e0;
    int d = 0;
    for (; d + 4 <= dn; d += 4) {
        v4f w[4];
#pragma unroll
        for (int k = 0; k < 4; ++k) w[k] = __builtin_nontemporal_load((const v4f*)(wp + (size_t)(d + k) * NADA));
#pragma unroll
        for (int k = 0; k < 4; ++k) {
            const LAS v4f* s4 = (const LAS v4f*)(sv + (d + k) * 20);
            const v4f s0 = s4[0], s1 = s4[1], s2 = s4[2], s3 = s4[3]; const float s16 = sv[(d + k) * 20 + 16];
#pragma unroll
            for (int v = 0; v < 4; ++v) { acc[v] += s0[v] * w[k]; acc[4 + v] += s1[v] * w[k]; acc[8 + v] += s2[v] * w[k]; acc[12 + v] += s3[v] * w[k]; }
            acc[16] += s16 * w[k];
        }
    }
    for (; d < dn; ++d) { const v4f w = *(const v4f*)(wp + (size_t)d * NADA);
#pragma unroll
        for (int v = 0; v < NVEC; ++v) acc[v] += sv[d * 20 + v] * w; }
    if (sp == 0) { const v4f b = *(const v4f*)(B + e0);
#pragma unroll
        for (int v = 0; v < NVEC; ++v) acc[v] += b; }
#pragma unroll
    for (int v = 0; v < NVEC; ++v)
#pragma unroll
        for (int e = 0; e < 4; ++e) atomicAdd(ada + (size_t)v * NADA + e0 + e, acc[v][e]);
    LDS_WAIT(); asm volatile("" ::: "memory");
}

__device__ __forceinline__ int kperm64(int d) { return 32 * ((d >> 4) & 1) + 16 * (d >> 5) + (d & 15); }
__device__ __forceinline__ int win_dst(int n) {
    if (n < 1536) return n;
    if (n < 1600) return 78 * 256 + kperm64(n - 1536);
    if (n < 5696) return 6 * 256 + (n - 1600);
    if (n < 6720) return 22 * 256 + (n - 5696);
    if (n < 7744) return 26 * 256 + (n - 6720);
    if (n < 11840) return 30 * 256 + (n - 7744);
    if (n < 11968) return 78 * 256 + 128 + (n - 11840);
    if (n < 12000) return 78 * 256 + 64 + (n - 11968);
    if (n < 16096) return 46 * 256 + (n - 12000);
    return 62 * 256 + (n - 16096);
}
__device__ __forceinline__ int wuq_dst(int n) { const int h = n / 192, dd = n % 192; return dd < 128 ? h * 128 + dd : 4096 + (h >> 1) * 128 + (h & 1) * 64 + kperm64(dd - 128); }
template <int MAP> __device__ __forceinline__ void transpose_item(const float* W, int K, int N, bf16* WT, int row_off, LAS float* scr, int item, int lane) {
    const int nblk = N / 32, kb = item / nblk, nb = item % nblk, k0 = 64 * kb, n0 = 32 * nb;
#pragma unroll 8
    for (int i = 0; i < 32; ++i) { const int kk = 2 * i + (lane >> 5); scr[kk * 33 + (lane & 31)] = __builtin_nontemporal_load(W + (size_t)(k0 + kk) * N + n0 + (lane & 31)); }
    LDS_WAIT(); asm volatile("" ::: "memory");
    const int c = lane & 7;
#pragma unroll
    for (int j = 0; j < 4; ++j) { const int n = (lane >> 3) + 8 * j; const LAS float* s = scr + (8 * c) * 33 + n;
        v4u o; o.x = pk2(s[0 * 33], s[1 * 33]); o.y = pk2(s[2 * 33], s[3 * 33]); o.z = pk2(s[4 * 33], s[5 * 33]); o.w = pk2(s[6 * 33], s[7 * 33]);
        const int dr = MAP == 1 ? win_dst(n0 + n) : MAP == 2 ? wuq_dst(n0 + n) : n0 + n;
        *(GAS v4u*)(WT + (size_t)(row_off + dr) * K + k0 + 8 * c) = o; }
    LDS_WAIT(); asm volatile("" ::: "memory");
}
__device__ __forceinline__ void cvt_row(const float* src, bf16* dst, int n, int lane) {
    for (int i = lane * 8; i < n; i += 512) { const v4f a = *(const v4f*)(src + i), b = *(const v4f*)(src + i + 4);
        v4u o; o.x = pk2(a[0], a[1]); o.y = pk2(a[2], a[3]); o.z = pk2(b[0], b[1]); o.w = pk2(b[2], b[3]); *(v4u*)(dst + i) = o; }
}
__device__ __forceinline__ void zero_row(bf16* dst, int n, int lane) { for (int i = lane * 8; i < n; i += 512) *(v4u*)(dst + i) = (v4u){0u, 0u, 0u, 0u}; }
__device__ __forceinline__ void sincos_acc(float a, float& c, float& s) {
    const double x = (double)a; const double q = __builtin_rint(x * 0.63661977236758134308);
    const double t = (x - q * 1.5707963267948965580) - q * 6.1232339957367658860e-17, t2 = t * t;
    double sp = 1.0 / 6227020800.0; sp = sp * t2 - 1.0 / 39916800.0; sp = sp * t2 + 1.0 / 362880.0; sp = sp * t2 - 1.0 / 5040.0; sp = sp * t2 + 1.0 / 120.0; sp = sp * t2 - 1.0 / 6.0; sp = sp * t2 + 1.0;
    const double sn = sp * t;
    double cp = -1.0 / 87178291200.0; cp = cp * t2 + 1.0 / 479001600.0; cp = cp * t2 - 1.0 / 3628800.0; cp = cp * t2 + 1.0 / 40320.0; cp = cp * t2 - 1.0 / 720.0; cp = cp * t2 + 1.0 / 24.0; cp = cp * t2 - 0.5; cp = cp * t2 + 1.0;
    const int k = (int)((long long)q & 3);
    const double cc = (k == 0) ? cp : (k == 1) ? -sn : (k == 2) ? -cp : sn;
    const double ss = (k == 0) ? sn : (k == 1) ? cp : (k == 2) ? -sn : -cp;
    c = (float)cc; s = (float)ss;
}
__device__ __forceinline__ float pow_int(double base, int j) { double r = 1.0; for (int i = 0; i < j; ++i) r *= base; return (float)r; }
__device__ __forceinline__ void modnorm_row(const float* xrow, const float* g, const float* sc, const float* sh, bf16* orow, int lane) {
    v4f v[16]; float s = 0.f;
#pragma unroll
    for (int j = 0; j < 16; ++j) { v[j] = *(const v4f*)(xrow + 4 * lane + 256 * j); s += (v[j][0] * v[j][0] + v[j][1] * v[j][1]) + (v[j][2] * v[j][2] + v[j][3] * v[j][3]); }
    const float rstd = 1.0f / sqrtf(wave_sum(s) * (1.0f / DM) + EPS);
#pragma unroll
    for (int j = 0; j < 16; ++j) { const int c = 4 * lane + 256 * j; const v4f gg = *(const v4f*)(g + c), a = *(const v4f*)(sc + c), b = *(const v4f*)(sh + c);
        const v4f y = (v[j] * rstd) * gg * (a + 1.0f) + b; v2u o; o.x = pk2(y[0], y[1]); o.y = pk2(y[2], y[3]); *(v2u*)(orow + c) = o; }
}
__device__ __forceinline__ void p01_gemv_and_copies(const Ctx& C) {
    if (C.wave < 4) for (int it = C.bx * 4 + C.wave; it < ADA_WCG * ADA_NSPLIT; it += 8 * C.G) p0_wave_item(C, it);
    LAS float* scr = (LAS float*)(C.lds + C.wave * 16384);
    const int gw = C.bx * NWAVES + C.wave, NGW = C.G * NWAVES, lane = C.lane;
    const Args& A = *C.a; unsigned char* ws = C.ws;
    constexpr int I_IN = (DM / 64) * (DIN / 32), I_UQ = (QLORA / 64) * (6144 / 32), I_UK = (KVLORA / 64) * (4096 / 32), I_OUT = (DM / 64) * (DM / 32), I_UP = (DM / 64) * (DFF / 32), I_DN = (DFF / 64) * (DM / 32);
    constexpr int NITEMS = I_IN + I_UQ + 2 * I_UK + I_OUT + I_UP + I_DN;
    for (int it = gw; it < NITEMS; it += NGW) {
        int r = it;
        if (r < I_IN) { transpose_item<1>(A.in[I_WIN], DM, DIN, (bf16*)(ws + WS_WIN), 0, scr, r, lane); continue; } r -= I_IN;
        if (r < I_UQ) { transpose_item<2>(A.in[I_WUQ], QLORA, 6144, (bf16*)(ws + WS_WUQ), 0, scr, r, lane); continue; } r -= I_UQ;
        if (r < I_UK) { transpose_item<0>(A.in[I_WUK], KVLORA, 4096, (bf16*)(ws + WS_WUKV), 0, scr, r, lane); continue; } r -= I_UK;
        if (r < I_UK) { transpose_item<0>(A.in[I_WUV], KVLORA, 4096, (bf16*)(ws + WS_WUKV), 4096, scr, r, lane); continue; } r -= I_UK;
        if (r < I_OUT) { transpose_item<0>(A.in[I_WOUT], DM, DM, (bf16*)(ws + WS_WOUT), 0, scr, r, lane); continue; } r -= I_OUT;
        if (r < I_UP) { transpose_item<0>(A.in[I_WUP], DM, DFF, (bf16*)(ws + WS_WUP), 0, scr, r, lane); continue; } r -= I_UP;
        transpose_item<0>(A.in[I_WDOWN], DFF, DM, (bf16*)(ws + WS_WDOWN), 0, scr, r, lane);
    }
    for (int i = gw; i < 32; i += NGW) zero_row((bf16*)(ws + WS_WIN) + (size_t)(78 * 256 + 96 + i) * DM, DM, lane);
    for (int i = gw; i < DEC_B * SPITCH; i += NGW) {
        const int b = i / SPITCH, l = i % SPITCH; const size_t kr = (size_t)SEQ + i, cr = (size_t)b * PAST + l;
        bf16* ck = (bf16*)(ws + WS_CKV) + kr * 512; bf16* kp = (bf16*)(ws + WS_KROPE) + kr * 64; bf16* ka = (bf16*)(ws + WS_KALL) + kr * 1024; bf16* va = (bf16*)(ws + WS_VALL) + kr * 1024; bf16* ki = (bf16*)(ws + WS_KI) + kr * 128;
        if (l < PAST) { cvt_row(A.in[I_CCKV] + cr * 512, ck, 512, lane); cvt_row(A.in[I_CKROPE] + cr * 64, kp, 64, lane); cvt_row(A.in[I_CK] + cr * 1024, ka, 1024, lane);
                        cvt_row(A.in[I_CV] + cr * 1024, va, 1024, lane); cvt_row(A.in[I_CKI] + cr * 128, ki, 128, lane); }
        else if (l >= SKEYS) { zero_row(ck, 512, lane); zero_row(kp, 64, lane); zero_row(ka, 1024, lane); zero_row(va, 1024, lane); zero_row(ki, 128, lane); }
    }
    {
        float* cm = (float*)(ws + WS_ROPE); float* sm = cm + SEQ * 32; float* cd = sm + SEQ * 32; float* sd = cd + SEQ * 16;
        for (int i = gw * 64 + lane; i < SEQ * 48; i += NGW * 64) {
            const int pos = i / 48, j = i % 48; float c, s;
            if (j < 32) { const float inv = pow_int(0.74989420933245582730, j); sincos_acc((float)pos * inv, c, s); cm[pos * 32 + j] = c; sm[pos * 32 + j] = s; }
            else { const int k = j - 32; const float inv = pow_int(0.44036660267178047359, k); sincos_acc((float)pos * inv, c, s); cd[pos * 16 + k] = c; sd[pos * 16 + k] = s; }
        }
    }
    if (C.wave >= 4) for (int it = (C.G + C.bx) * 4 + (C.wave - 4); it < ADA_WCG * ADA_NSPLIT; it += 8 * C.G) p0_wave_item(C, it);
}
__device__ __forceinline__ void p1_modnorm(const Ctx& C) {
    const int gw = C.bx * NWAVES + C.wave, NGW = C.G * NWAVES, lane = C.lane;
    const Args& A = *C.a; unsigned char* ws = C.ws;
    {
        const float* ada = (const float*)(ws + WS_ADA);
        for (int r = gw; r < NROW; r += NGW) {
            const float* xr = r < SEQ ? A.in[I_XP] + (size_t)r * DM : A.in[I_XS] + (size_t)(r - SEQ) * DM; const float* av = ada + (size_t)row_vec(r) * NADA;
            modnorm_row(xr, A.in[I_G1], av + 1 * DM, av + 0 * DM, (bf16*)(ws + WS_XN) + (size_t)r * DM, lane);
        }
    }
}
__device__ __forceinline__ void p3_norms(const Ctx& C) {
    const int gw = C.bx * NWAVES + C.wave, NGW = C.G * NWAVES, lane = C.lane; const Args& A = *C.a; unsigned char* ws = C.ws;
    const float* gq = A.in[I_GQ]; const float* gkv = A.in[I_GKV];
    for (int r = gw; r < NROW; r += NGW) {
        {
            const float* x = (const float*)(ws + WS_QRAW) + (size_t)r * QLORA; v4f v[4]; float s = 0.f;
#pragma unroll
            for (int j = 0; j < 4; ++j) { v[j] = *(const v4f*)(x + 4 * lane + 256 * j); s += (v[j][0] * v[j][0] + v[j][1] * v[j][1]) + (v[j][2] * v[j][2] + v[j][3] * v[j][3]); }
            const float rstd = 1.0f / sqrtf(wave_sum(s) * (1.0f / QLORA) + EPS); bf16* o = (bf16*)(ws + WS_QN) + (size_t)r * QLORA;
#pragma unroll
            for (int j = 0; j < 4; ++j) { const int c = 4 * lane + 256 * j; const v4f y = (v[j] * rstd) * *(const v4f*)(gq + c); v2u w; w.x = pk2(y[0], y[1]); w.y = pk2(y[2], y[3]); *(v2u*)(o + c) = w; }
        }
        {
            const float* x = (const float*)(ws + WS_CKVRAW) + (size_t)r * KVLORA; v4f v[2]; float s = 0.f;
#pragma unroll
            for (int j = 0; j < 2; ++j) { v[j] = *(const v4f*)(x + 4 * lane + 256 * j); s += (v[j][0] * v[j][0] + v[j][1] * v[j][1]) + (v[j][2] * v[j][2] + v[j][3] * v[j][3]); }
            const float rstd = 1.0f / sqrtf(wave_sum(s) * (1.0f / KVLORA) + EPS);
            float* of = C.out + (r < SEQ ? O_CKV_P + (size_t)r * KVLORA : O_CKV_S + (size_t)(r - SEQ) * KVLORA); bf16* ob = (bf16*)(ws + WS_CKV) + (size_t)row_key(r) * KVLORA;
#pragma unroll
            for (int j = 0; j < 2; ++j) { const int c = 4 * lane + 256 * j; const v4f y = (v[j] * rstd) * *(const v4f*)(gkv + c); *(v4f*)(of + c) = y; v2u w; w.x = pk2(y[0], y[1]); w.y = pk2(y[2], y[3]); *(v2u*)(ob + c) = w; }
        }
    }
}
template <int S> __device__ __forceinline__ void sample_row_sum(const Ctx& C, int i, const float* base, const float* gate, v4f (&v)[2], float& rstd) {
    const float* slab = (const float*)(C.ws + WS_SLAB); LAS float* red = (LAS float*)C.lds; float ss = 0.f;
#pragma unroll
    for (int j = 0; j < 2; ++j) { const int c = 512 * C.wave + 4 * C.lane + 256 * j; v4f a = {0.f, 0.f, 0.f, 0.f};
#pragma unroll
        for (int s = 0; s < S; ++s) a += *(const v4f*)(slab + ((size_t)s * 256 + i) * DM + c);
        v[j] = *(const v4f*)(base + c) + *(const v4f*)(gate + c) * a; ss += (v[j][0] * v[j][0] + v[j][1] * v[j][1]) + (v[j][2] * v[j][2] + v[j][3] * v[j][3]); }
    ss = wave_sum(ss); __syncthreads(); if (C.lane == 0) red[C.wave] = ss; __syncthreads();
    float t = 0.f;
#pragma unroll
    for (int w = 0; w < 8; ++w) t += red[w];
    rstd = 1.0f / sqrtf(t * (1.0f / DM) + EPS);
}
__device__ __forceinline__ void p9_h2(const Ctx& C) {
    const int gw = C.bx * NWAVES + C.wave, NGW = C.G * NWAVES; const Args& A = *C.a; const float* ada = (const float*)(C.ws + WS_ADA);
    for (int i = C.bx; i < NSAMP; i += C.G) {
        const int r = SEQ + i; const float* av = ada + (size_t)row_vec(r) * NADA; v4f v[2]; float rstd;
        sample_row_sum<SPLIT_OUT>(C, i, A.in[I_XS] + (size_t)i * DM, av + 2 * DM, v, rstd);
#pragma unroll
        for (int j = 0; j < 2; ++j) { const int c = 512 * C.wave + 4 * C.lane + 256 * j; *(v4f*)(C.out + O_Y + (size_t)r * DM + c) = v[j];
            const v4f y = (v[j] * rstd) * *(const v4f*)(A.in[I_G2] + c) * (*(const v4f*)(av + 4 * DM + c) + 1.0f) + *(const v4f*)(av + 3 * DM + c);
            v2u o; o.x = pk2(y[0], y[1]); o.y = pk2(y[2], y[3]); *(v2u*)((bf16*)(C.ws + WS_XN) + (size_t)r * DM + c) = o; }
    }
    for (int r = gw; r < SEQ; r += NGW) { const float* av = ada + (size_t)row_vec(r) * NADA;
        modnorm_row(C.out + O_Y + (size_t)r * DM, A.in[I_G2], av + 4 * DM, av + 3 * DM, (bf16*)(C.ws + WS_XN) + (size_t)r * DM, C.lane); }
}
__device__ __forceinline__ void p12_final(const Ctx& C) {
    const int gw = C.bx * NWAVES + C.wave, NGW = C.G * NWAVES, lane = C.lane; const float* g = C.a->in[I_GF]; const float* ada = (const float*)(C.ws + WS_ADA);
    for (int i = C.bx; i < NSAMP; i += C.G) {
        const int r = SEQ + i; const float* av = ada + (size_t)row_vec(r) * NADA; v4f v[2]; float rstd; float* y = C.out + O_Y + (size_t)r * DM;
        sample_row_sum<SPLIT_DOWN>(C, i, y, av + 5 * DM, v, rstd);
#pragma unroll
        for (int j = 0; j < 2; ++j) { const int c = 512 * C.wave + 4 * C.lane + 256 * j; *(v4f*)(y + c) = (v[j] * rstd) * *(const v4f*)(g + c); }
    }
    for (int r = gw; r < SEQ; r += NGW) {
        float* x = C.out + O_Y + (size_t)r * DM; v4f v[16]; float s = 0.f;
#pragma unroll
        for (int j = 0; j < 16; ++j) { v[j] = *(const v4f*)(x + 4 * lane + 256 * j); s += (v[j][0] * v[j][0] + v[j][1] * v[j][1]) + (v[j][2] * v[j][2] + v[j][3] * v[j][3]); }
        const float rstd = 1.0f / sqrtf(wave_sum(s) * (1.0f / DM) + EPS);
#pragma unroll
        for (int j = 0; j < 16; ++j) { const int c = 4 * lane + 256 * j; *(v4f*)(x + c) = (v[j] * rstd) * *(const v4f*)(g + c); }
    }
}
namespace att {
typedef short bf16x8 __attribute__((ext_vector_type(8)));
typedef short s16x4 __attribute__((ext_vector_type(4)));
typedef float f32x16 __attribute__((ext_vector_type(16)));
typedef unsigned u32x4 __attribute__((ext_vector_type(4)));
typedef unsigned long long u64;
constexpr int L_KN = 0, L_V = 32768, L_KR = 81920, L_WS = 98304, L_END = 100352;
#define SBAR() __builtin_amdgcn_sched_barrier(0)
#define BAR() do { __builtin_amdgcn_s_barrier(); asm volatile("" ::: "memory"); } while (0)
__device__ __forceinline__ int crow(int r, int hi) { return (r & 3) + 8 * (r >> 2) + 4 * hi; }
__device__ __forceinline__ unsigned cvtpk(float lo, float hi) { return pg8::cvt_pk_bf16(lo, hi); }
__device__ __forceinline__ int swap23(int k) { return (k & ~0xC) | ((k & 4) << 1) | ((k & 8) >> 1); }
__device__ __forceinline__ void glds(const void* g, LAS unsigned char* l) { __builtin_amdgcn_global_load_lds((const unsigned*)g, (LAS unsigned*)l, 16, 0, 0); }
template <int OFF> __device__ __forceinline__ s16x4 tr_read(unsigned vb) { s16x4 r; asm volatile("ds_read_b64_tr_b16 %0, %1 offset:%2" : "=&v"(r) : "v"(vb), "i"(OFF) : "memory"); return r; }
constexpr int v_rd_off(int d0, int ks, int half) { return d0 * 512 + ks * 4096 + half * 2048; }
__device__ __forceinline__ unsigned v_rd_base(int lane) { return ((lane & 3) << 3) | (((lane >> 2) & 3) << 6) | (((lane >> 4) & 1) << 5) | (((lane >> 5) & 1) << 8); }
struct VFrag { s16x4 l0, h0, l1, h1, l2, h2, l3, h3; };
template <int D0> __device__ __forceinline__ void pv_read(VFrag& f, unsigned vb) {
    f.l0 = tr_read<v_rd_off(D0, 0, 0)>(vb); f.h0 = tr_read<v_rd_off(D0, 0, 1)>(vb); f.l1 = tr_read<v_rd_off(D0, 1, 0)>(vb); f.h1 = tr_read<v_rd_off(D0, 1, 1)>(vb);
    f.l2 = tr_read<v_rd_off(D0, 2, 0)>(vb); f.h2 = tr_read<v_rd_off(D0, 2, 1)>(vb); f.l3 = tr_read<v_rd_off(D0, 3, 0)>(vb); f.h3 = tr_read<v_rd_off(D0, 3, 1)>(vb);
}
__device__ __forceinline__ void pv_mma(f32x16& od, const VFrag& f, bf16x8 pa0, bf16x8 pa1, bf16x8 pa2, bf16x8 pa3) {
#define PK(L, H) (bf16x8){L[0], L[1], L[2], L[3], H[0], H[1], H[2], H[3]}
    od = __builtin_amdgcn_mfma_f32_32x32x16_bf16(pa0, PK(f.l0, f.h0), od, 0, 0, 0);
    od = __builtin_amdgcn_mfma_f32_32x32x16_bf16(pa1, PK(f.l1, f.h1), od, 0, 0, 0);
    od = __builtin_amdgcn_mfma_f32_32x32x16_bf16(pa2, PK(f.l2, f.h2), od, 0, 0, 0);
    od = __builtin_amdgcn_mfma_f32_32x32x16_bf16(pa3, PK(f.l3, f.h3), od, 0, 0, 0);
#undef PK
}
__device__ __forceinline__ void pv_all(f32x16 (&o)[4], unsigned vb, bf16x8 pa0, bf16x8 pa1, bf16x8 pa2, bf16x8 pa3) {
    VFrag fa, fb;
    pv_read<0>(fa, vb);
    pv_read<1>(fb, vb); asm volatile("s_waitcnt lgkmcnt(8)" ::: "memory"); SBAR(); pv_mma(o[0], fa, pa0, pa1, pa2, pa3); SBAR();
    pv_read<2>(fa, vb); asm volatile("s_waitcnt lgkmcnt(8)" ::: "memory"); SBAR(); pv_mma(o[1], fb, pa0, pa1, pa2, pa3); SBAR();
    pv_read<3>(fb, vb); asm volatile("s_waitcnt lgkmcnt(8)" ::: "memory"); SBAR(); pv_mma(o[2], fa, pa0, pa1, pa2, pa3); SBAR();
    asm volatile("s_waitcnt lgkmcnt(0)" ::: "memory"); SBAR(); pv_mma(o[3], fb, pa0, pa1, pa2, pa3);
}

struct Desc {
    const bf16* K; int ldk; const bf16* Kr; const bf16* V; int ldv; int NT, nvis;
    u64 lastmask;
    int tok0, tmask, hshift, hcol0, nvalid;
};
template <int KIND>
__device__ __forceinline__ void attn_unit(LAS unsigned char* lds, const Desc& D, const bf16* QN, const bf16* QR, const u64* MASK, const bf16* GATE, const bf16* ADDB, bf16* OUT, int wid, int lane) {
    constexpr int NQ = KIND == 0 ? 12 : 8;
    asm volatile("" : "+v"(lane));
    const int r32 = lane & 31, hi = lane >> 5;
    LAS float* wsf = (LAS float*)(lds + L_WS) + wid * 64;
    asm volatile("s_waitcnt vmcnt(0) lgkmcnt(0)" ::: "memory"); BAR();
    const bool active = D.nvis > 0;
    const int qtok = D.tok0 + (r32 & D.tmask), qcol = D.hcol0 + (r32 >> D.hshift) * 128;
    bf16x8 qr[NQ];
    {
        const bf16* qp = QN + (size_t)qtok * 4096 + qcol + hi * 8;
#pragma unroll
        for (int d0 = 0; d0 < 8; ++d0) qr[d0] = *(const bf16x8*)(qp + d0 * 16);
        if constexpr (KIND == 0) { const bf16* qp2 = QR + (size_t)qtok * 2048 + (qcol >> 1) + hi * 8;
#pragma unroll
            for (int d0 = 0; d0 < 4; ++d0) qr[8 + d0] = *(const bf16x8*)(qp2 + d0 * 16); }
#pragma unroll
        for (int d0 = 0; d0 < NQ; ++d0) asm volatile("" : "+v"(qr[d0]));
    }
    const u64* mrow = MASK + (size_t)qtok * 128;
    int kn_off[2], v_off[2], kr_off = 0;
#pragma unroll
    for (int i = 0; i < 2; ++i) {
        const int row = 8 * wid + 4 * i + (lane >> 4), chunk = (lane & 15) ^ (row & 15); kn_off[i] = row * D.ldk + chunk * 8;
        const int kk = 8 * wid + ((lane & 31) >> 2), k = swap23(kk), c = 32 * (2 * i + (lane >> 5)) + (lane & 3) * 8; v_off[i] = k * D.ldv + c;
    }
    if constexpr (KIND == 0) { const int row = 8 * wid + (lane >> 3), chunk = (lane & 7) ^ ((row >> 1) & 7); kr_off = row * 64 + chunk * 8; }
#define STAGE(j, b, bv) do { const bf16* kb_ = D.K + (size_t)(j) * 64 * D.ldk; const bf16* vb_ = D.V + (size_t)(j) * 64 * D.ldv; \
        glds(kb_ + kn_off[0], lds + L_KN + (b) * 16384 + (2 * wid) * 1024); glds(kb_ + kn_off[1], lds + L_KN + (b) * 16384 + (2 * wid + 1) * 1024); \
        glds(vb_ + v_off[0], lds + L_V + (bv) * 16384 + (2 * wid) * 1024); glds(vb_ + v_off[1], lds + L_V + (bv) * 16384 + (2 * wid + 1) * 1024); \
        if constexpr (KIND == 0) glds(D.Kr + (size_t)(j) * 64 * 64 + kr_off, lds + L_KR + (b) * 8192 + wid * 1024); } while (0)
    const unsigned kq = (unsigned)(r32 * 256), kt = (unsigned)((hi ^ (r32 & 15)) << 4);
    const unsigned krq = (unsigned)(r32 * 128), krt = (unsigned)((hi ^ ((r32 >> 1) & 7)) << 4);
    const unsigned vb0 = (unsigned)(uintptr_t)(lds + L_V) + v_rd_base(lane);
    float lf = 0.f; f32x16 of[4];
    bool redo;
    {
        float l_reg = 0.f; f32x16 o[4];
    #pragma unroll
        for (int d = 0; d < 4; ++d)
    #pragma unroll
            for (int r = 0; r < 16; ++r) o[d][r] = 0.f;
        u64 mw_next = ~0ull;
        if constexpr (KIND == 1) mw_next = mrow[0];
        STAGE(0, 0, 0);
        const int half = wid >> 2; int vs = 0;
        bf16x8 pa0, pa1, pa2, pa3; { const bf16x8 z8 = {0, 0, 0, 0, 0, 0, 0, 0}; pa0 = z8; pa1 = z8; pa2 = z8; pa3 = z8; }
        for (int j = 0; j <= D.NT; ++j) {
            asm volatile("s_waitcnt vmcnt(0)" ::: "memory"); BAR();
            u64 mw = mw_next;
            const int vs1 = vs == 2 ? 0 : vs + 1, vsm = vs == 0 ? 2 : vs - 1;
            if (j + 1 < D.NT) { STAGE(j + 1, (j + 1) & 1, vs1); if constexpr (KIND == 1) mw_next = mrow[j + 1]; }
            if constexpr (KIND == 0) mw = (j == D.NT - 1) ? D.lastmask : ~0ull;
            if (half == 1 && j >= 1 && j - 1 < D.nvis) pv_all(o, vb0 + (unsigned)(vsm * 16384), pa0, pa1, pa2, pa3);
            if (j < D.NT && j < D.nvis) {
                const int b = j & 1;
                f32x16 p0, p1;
                {
                    LAS const unsigned char* kb = lds + L_KN + b * 16384 + kq;
                    constexpr int NSTEP = KIND == 0 ? 12 : 8;
                    bf16x8 ka0, ka1, kb0, kb1, kc0, kc1, kd0, kd1;
    #define KLOAD(d0_, X0, X1) do { if ((d0_) < 8) { const unsigned off_ = kt ^ (unsigned)((d0_) << 5); X0 = *(LAS const bf16x8*)(kb + off_); X1 = *(LAS const bf16x8*)(kb + 8192 + off_); } \
            else { LAS const unsigned char* kr_ = lds + L_KR + b * 8192 + krq; const unsigned off_ = krt ^ (unsigned)(((d0_) - 8) << 5); X0 = *(LAS const bf16x8*)(kr_ + off_); X1 = *(LAS const bf16x8*)(kr_ + 4096 + off_); } } while (0)
    #define QK2(S_, A0, A1, B0, B1) do { \
            if ((S_) == 0) { const f32x16 z_ = {0.f, 0.f, 0.f, 0.f, 0.f, 0.f, 0.f, 0.f, 0.f, 0.f, 0.f, 0.f, 0.f, 0.f, 0.f, 0.f}; p0 = __builtin_amdgcn_mfma_f32_32x32x16_bf16(A0, qr[0], z_, 0, 0, 0); p1 = __builtin_amdgcn_mfma_f32_32x32x16_bf16(A1, qr[0], z_, 0, 0, 0); } \
            else { p0 = __builtin_amdgcn_mfma_f32_32x32x16_bf16(A0, qr[S_], p0, 0, 0, 0); p1 = __builtin_amdgcn_mfma_f32_32x32x16_bf16(A1, qr[S_], p1, 0, 0, 0); } \
            p0 = __builtin_amdgcn_mfma_f32_32x32x16_bf16(B0, qr[(S_) + 1], p0, 0, 0, 0); p1 = __builtin_amdgcn_mfma_f32_32x32x16_bf16(B1, qr[(S_) + 1], p1, 0, 0, 0); } while (0)
                    KLOAD(0, ka0, ka1); KLOAD(1, kb0, kb1);
    #pragma unroll
                    for (int g = 0; g < NSTEP; g += 4) {
                        KLOAD(g + 2, kc0, kc1); KLOAD(g + 3, kd0, kd1);
                        SBAR();
                        QK2(g, ka0, ka1, kb0, kb1);
                        SBAR();
                        if (g + 4 < NSTEP) { KLOAD(g + 4, ka0, ka1); KLOAD(g + 5, kb0, kb1); }
                        SBAR();
                        QK2(g + 2, kc0, kc1, kd0, kd1);
                        SBAR();
                    }
    #undef QK2
    #undef KLOAD
                }
                float ps = 0.f;
    #pragma unroll
                for (int r = 0; r < 16; ++r) { p0[r] = __builtin_amdgcn_exp2f(p0[r]); p1[r] = __builtin_amdgcn_exp2f(p1[r]); }
                if (KIND == 1 || mw != ~0ull) {
                    const unsigned lo = (unsigned)mw >> (4 * hi), hh = (unsigned)(mw >> 32) >> (4 * hi);
    #pragma unroll
                    for (int r = 0; r < 16; ++r) { const int bit = (r & 3) + 8 * (r >> 2);
                        p0[r] = __uint_as_float(__float_as_uint(p0[r]) & (unsigned)__builtin_amdgcn_sbfe((int)lo, bit, 1));
                        p1[r] = __uint_as_float(__float_as_uint(p1[r]) & (unsigned)__builtin_amdgcn_sbfe((int)hh, bit, 1)); }
                }
    #pragma unroll
                for (int r = 0; r < 16; ++r) ps += p0[r] + p1[r];
                { auto rr = __builtin_amdgcn_permlane32_swap(__float_as_uint(ps), __float_as_uint(ps), false, false); ps = __uint_as_float(rr[0]) + __uint_as_float(rr[1]); }
                l_reg += ps;
    #define PK4(P, BASE, OUT) do { unsigned a0 = cvtpk(P[BASE + 0], P[BASE + 1]), a1 = cvtpk(P[BASE + 2], P[BASE + 3]); \
        unsigned b0 = cvtpk(P[BASE + 4], P[BASE + 5]), b1 = cvtpk(P[BASE + 6], P[BASE + 7]); \
        auto r0 = __builtin_amdgcn_permlane32_swap(a0, b0, false, false); auto r1 = __builtin_amdgcn_permlane32_swap(a1, b1, false, false); \
        u32x4 w = {r0[0], r1[0], r0[1], r1[1]}; OUT = __builtin_bit_cast(bf16x8, w); } while (0)
                PK4(p0, 0, pa0); PK4(p0, 8, pa1); PK4(p1, 0, pa2); PK4(p1, 8, pa3);
    #undef PK4
                if (half == 0) pv_all(o, vb0 + (unsigned)(vs * 16384), pa0, pa1, pa2, pa3);
            }
            vs = vs1;
        }
        bool ok = l_reg > 1e-30f && l_reg < 1e30f;
#pragma unroll
        for (int d = 0; d < 4; ++d)
#pragma unroll
            for (int r = 0; r < 16; ++r) ok = ok && (fabsf(o[d][r]) < 1e30f);
        const bool bad = active && !__all(ok);
        if (!bad) { lf = l_reg;
#pragma unroll
            for (int d = 0; d < 4; ++d) of[d] = o[d]; }
        LAS unsigned* flags = (LAS unsigned*)(lds + L_END);
        if (lane == 0) flags[wid] = bad ? 1u : 0u;
        asm volatile("s_waitcnt vmcnt(0) lgkmcnt(0)" ::: "memory"); BAR();
        unsigned any = 0;
#pragma unroll
        for (int w = 0; w < 8; ++w) any |= flags[w];
        redo = any != 0u;
    }
    if (__builtin_expect(redo, 0)) {
        asm volatile("s_waitcnt vmcnt(0) lgkmcnt(0)" ::: "memory"); BAR();
        float l_reg = 0.f; f32x16 o[4];
        f32x16 negm;
    #pragma unroll
        for (int r = 0; r < 16; ++r) negm[r] = 0.f;
    #pragma unroll
        for (int d = 0; d < 4; ++d)
    #pragma unroll
            for (int r = 0; r < 16; ++r) o[d][r] = 0.f;
        u64 mw_next = ~0ull;
        if constexpr (KIND == 1) mw_next = mrow[0];
        STAGE(0, 0, 0);
        for (int j = 0; j < D.NT; ++j) {
            asm volatile("s_waitcnt vmcnt(0)" ::: "memory"); BAR();
            u64 mw = mw_next;
            if (j + 1 < D.NT) { STAGE(j + 1, (j + 1) & 1, (j + 1) % 3); if constexpr (KIND == 1) mw_next = mrow[j + 1]; }
            if constexpr (KIND == 0) mw = (j == D.NT - 1) ? D.lastmask : ~0ull;
            if (j < D.nvis) {
                const int b = j & 1;
                f32x16 p0, p1;
                {
                    LAS const unsigned char* kb = lds + L_KN + b * 16384 + kq;
                    constexpr int NSTEP = KIND == 0 ? 12 : 8;
                    bf16x8 ka0, ka1, kb0, kb1;
    #define KLOAD(d0_, X0, X1) do { if ((d0_) < 8) { const unsigned off_ = kt ^ (unsigned)((d0_) << 5); X0 = *(LAS const bf16x8*)(kb + off_); X1 = *(LAS const bf16x8*)(kb + 8192 + off_); } \
            else { LAS const unsigned char* kr_ = lds + L_KR + b * 8192 + krq; const unsigned off_ = krt ^ (unsigned)(((d0_) - 8) << 5); X0 = *(LAS const bf16x8*)(kr_ + off_); X1 = *(LAS const bf16x8*)(kr_ + 4096 + off_); } } while (0)
                    KLOAD(0, ka0, ka1);
    #pragma unroll
                    for (int d0 = 0; d0 < NSTEP; d0 += 2) {
                        KLOAD(d0 + 1, kb0, kb1);
                        if (d0 == 0) { p0 = __builtin_amdgcn_mfma_f32_32x32x16_bf16(ka0, qr[0], negm, 0, 0, 0); p1 = __builtin_amdgcn_mfma_f32_32x32x16_bf16(ka1, qr[0], negm, 0, 0, 0); }
                        else { p0 = __builtin_amdgcn_mfma_f32_32x32x16_bf16(ka0, qr[d0], p0, 0, 0, 0); p1 = __builtin_amdgcn_mfma_f32_32x32x16_bf16(ka1, qr[d0], p1, 0, 0, 0); }
                        SBAR();
                        if (d0 + 2 < NSTEP) KLOAD(d0 + 2, ka0, ka1);
                        p0 = __builtin_amdgcn_mfma_f32_32x32x16_bf16(kb0, qr[d0 + 1], p0, 0, 0, 0); p1 = __builtin_amdgcn_mfma_f32_32x32x16_bf16(kb1, qr[d0 + 1], p1, 0, 0, 0); SBAR();
                    }
    #undef KLOAD
                }
                float pmax = fmaxf(fmaxf(p0[0], p0[1]), p0[2]);
    #pragma unroll
                for (int r = 3; r < 15; r += 2) pmax = fmaxf(fmaxf(pmax, p0[r]), p0[r + 1]);
                pmax = fmaxf(pmax, p0[15]);
    #pragma unroll
                for (int r = 0; r < 16; r += 2) pmax = fmaxf(fmaxf(pmax, p1[r]), p1[r + 1]);
                { auto rr = __builtin_amdgcn_permlane32_swap(__float_as_uint(pmax), __float_as_uint(pmax), false, false); pmax = fmaxf(__uint_as_float(rr[0]), __uint_as_float(rr[1])); }
                float alpha = 1.f;
                if (!__all(pmax <= 8.0f)) {
                    const float d = fmaxf(pmax, 0.f); alpha = __builtin_amdgcn_exp2f(-d);
    #pragma unroll
                    for (int r = 0; r < 16; ++r) { p0[r] -= d; p1[r] -= d; negm[r] -= d; }
                }
                float ps = 0.f;
    #pragma unroll
                for (int r = 0; r < 16; ++r) { p0[r] = __builtin_amdgcn_exp2f(p0[r]); p1[r] = __builtin_amdgcn_exp2f(p1[r]); }
                if (KIND == 1 || mw != ~0ull) {
                    const unsigned lo = (unsigned)mw >> (4 * hi), hh = (unsigned)(mw >> 32) >> (4 * hi);
    #pragma unroll
                    for (int r = 0; r < 16; ++r) { const int bit = (r & 3) + 8 * (r >> 2);
                        p0[r] = __uint_as_float(__float_as_uint(p0[r]) & (unsigned)__builtin_amdgcn_sbfe((int)lo, bit, 1));
                        p1[r] = __uint_as_float(__float_as_uint(p1[r]) & (unsigned)__builtin_amdgcn_sbfe((int)hh, bit, 1)); }
                }
    #pragma unroll
                for (int r = 0; r < 16; ++r) ps += p0[r] + p1[r];
                { auto rr = __builtin_amdgcn_permlane32_swap(__float_as_uint(ps), __float_as_uint(ps), false, false); ps = __uint_as_float(rr[0]) + __uint_as_float(rr[1]); }
                l_reg = l_reg * alpha + ps;
                bf16x8 pa0, pa1, pa2, pa3;
    #define PK4(P, BASE, OUT) do { unsigned a0 = cvtpk(P[BASE + 0], P[BASE + 1]), a1 = cvtpk(P[BASE + 2], P[BASE + 3]); \
        unsigned b0 = cvtpk(P[BASE + 4], P[BASE + 5]), b1 = cvtpk(P[BASE + 6], P[BASE + 7]); \
        auto r0 = __builtin_amdgcn_permlane32_swap(a0, b0, false, false); auto r1 = __builtin_amdgcn_permlane32_swap(a1, b1, false, false); \
        u32x4 w = {r0[0], r1[0], r0[1], r1[1]}; OUT = __builtin_bit_cast(bf16x8, w); } while (0)
                PK4(p0, 0, pa0); PK4(p0, 8, pa1); PK4(p1, 0, pa2); PK4(p1, 8, pa3);
    #undef PK4
                if (__any(alpha < 1.f)) {
                    if (hi == 0) wsf[32 + r32] = alpha;
                    asm volatile("s_waitcnt lgkmcnt(0)" ::: "memory");
    #pragma unroll
                    for (int r = 0; r < 16; ++r) { const float a = wsf[32 + crow(r, hi)];
    #pragma unroll
                        for (int d = 0; d < 4; ++d) o[d][r] *= a; }
                }
                const unsigned vb = vb0 + (unsigned)((j % 3) * 16384);
                pv_all(o, vb, pa0, pa1, pa2, pa3);
            }
        }

#undef STAGE
        lf = l_reg;
#pragma unroll
        for (int d = 0; d < 4; ++d) of[d] = o[d];
        asm volatile("s_waitcnt vmcnt(0) lgkmcnt(0)" ::: "memory"); BAR();
    }
    if (active) {
        if (hi == 0) wsf[r32] = lf;
        asm volatile("s_waitcnt lgkmcnt(0)" ::: "memory");
        LAS unsigned char* ost = lds + wid * 8192;
#pragma unroll
        for (int r = 0; r < 16; ++r) { const float rl = __builtin_amdgcn_rcpf(wsf[crow(r, hi)]); const int row = crow(r, hi);
#pragma unroll
            for (int d = 0; d < 4; ++d) *(LAS unsigned short*)(ost + row * 256 + (32 * d + r32) * 2) = (unsigned short)f2bf(of[d][r] * rl); }
        asm volatile("s_waitcnt lgkmcnt(0)" ::: "memory");
#pragma unroll
        for (int i = 0; i < 8; ++i) {
            const int lr = 4 * i + (lane >> 4), cc = (lane & 15) * 8;
            if (lr < D.nvalid) {
                const bf16x8 ov = *(LAS const bf16x8*)(ost + lr * 256 + cc * 2);
                const size_t idx = (size_t)(D.tok0 + (lr & D.tmask)) * 4096 + D.hcol0 + (lr >> D.hshift) * 128 + cc;
                const bf16x8 g = *(const bf16x8*)(GATE + idx);
                bf16x8 ab; if constexpr (KIND == 1) ab = *(const bf16x8*)(ADDB + idx);
                u32x4 w;
#pragma unroll
                for (int e = 0; e < 4; ++e) {
                    float x0 = bf2f((unsigned short)ov[2 * e]) * bf2f((unsigned short)g[2 * e]), x1 = bf2f((unsigned short)ov[2 * e + 1]) * bf2f((unsigned short)g[2 * e + 1]);
                    if constexpr (KIND == 1) { x0 += bf2f((unsigned short)ab[2 * e]); x1 += bf2f((unsigned short)ab[2 * e + 1]); }
                    w[e] = pk2(x0, x1);
                }
                *(u32x4*)(OUT + idx) = w;
            }
        }
    }
}

__device__ __forceinline__ void idx_unit(LAS unsigned char* lds, const bf16* QI, const float* WI, const bf16* KI, int tok0, int NT, int nvalid, float* srow0, size_t spitch, int wid, int lane) {
    asm volatile("" : "+v"(lane));
    const int r32 = lane & 31, hi = lane >> 5;
    asm volatile("s_waitcnt vmcnt(0) lgkmcnt(0)" ::: "memory"); BAR();
    bf16x8 qa[2][8]; float wv[2][16];
#pragma unroll
    for (int t = 0; t < 2; ++t) { const int tok = tok0 + 2 * wid + t; const bf16* qp = QI + (size_t)tok * 4096 + r32 * 128 + hi * 8;
#pragma unroll
        for (int d0 = 0; d0 < 8; ++d0) qa[t][d0] = *(const bf16x8*)(qp + d0 * 16);
#pragma unroll
        for (int r = 0; r < 16; ++r) wv[t][r] = WI[(size_t)tok * 32 + crow(r, hi)]; }
    int kn_off[2];
#pragma unroll
    for (int i = 0; i < 2; ++i) { const int row = 8 * wid + 4 * i + (lane >> 4), chunk = (lane & 15) ^ (row & 15); kn_off[i] = row * 128 + chunk * 8; }
#define ISTAGE2(J, b) do { const bf16* kb_ = KI + (size_t)(J) * 128 * 128; glds(kb_ + kn_off[0], lds + (b) * 32768 + (2 * wid) * 1024); glds(kb_ + kn_off[1], lds + (b) * 32768 + (2 * wid + 1) * 1024); \
        if (2 * (J) + 1 < NT) { glds(kb_ + 8192 + kn_off[0], lds + (b) * 32768 + 16384 + (2 * wid) * 1024); glds(kb_ + 8192 + kn_off[1], lds + (b) * 32768 + 16384 + (2 * wid + 1) * 1024); } } while (0)
    const unsigned kq = (unsigned)(r32 * 256), kt = (unsigned)((hi ^ (r32 & 15)) << 4);
    float* s0 = srow0 + (size_t)(2 * wid) * spitch; float* s1 = s0 + spitch;
    const int NS2 = (NT + 1) >> 1;
    ISTAGE2(0, 0);
    for (int J = 0; J < NS2; ++J) {
        if (J == 0) asm volatile("s_waitcnt vmcnt(0)" ::: "memory");
        else asm volatile("s_waitcnt vmcnt(4)" ::: "memory");
        BAR();
        if (J + 1 < NS2) ISTAGE2(J + 1, (J + 1) & 1);
        const int nq = (2 * J + 1 < NT) ? 4 : 2;
        const unsigned kba = (unsigned)(size_t)(lds + (J & 1) * 32768 + kq);
        bf16x8 kfa[8], kfb[8];
        float sc[2][4];
#define IREAD(KF, Q) do { _Pragma("unroll") for (int d0 = 0; d0 < 8; ++d0) asm volatile("ds_read_b128 %0, %1 offset:%2" : "=v"(KF[d0]) : "v"(kba + (kt ^ (unsigned)(d0 << 5))), "i"((Q) * 8192) : "memory"); } while (0)
#define IMMA(ACC, KF, T) do { _Pragma("unroll") for (int r = 0; r < 16; ++r) ACC[r] = 0.f; \
            _Pragma("unroll") for (int d0 = 0; d0 < 8; ++d0) ACC = __builtin_amdgcn_mfma_f32_32x32x16_bf16(qa[T][d0], KF[d0], ACC, 0, 0, 0); } while (0)
#define IRED(ACC, T, Q) do { float s_ = 0.f; \
            _Pragma("unroll") for (int r = 0; r < 16; ++r) s_ += __builtin_amdgcn_fmed3f(ACC[r], 0.f, 3.0e38f) * wv[T][r]; \
            auto rr_ = __builtin_amdgcn_permlane32_swap(__float_as_uint(s_), __float_as_uint(s_), false, false); \
            sc[T][Q] = __uint_as_float(rr_[0]) + __uint_as_float(rr_[1]); } while (0)
        f32x16 accA, accB;
        IREAD(kfa, 0);
        IREAD(kfb, 1); asm volatile("s_waitcnt lgkmcnt(8)" ::: "memory"); SBAR();
        IMMA(accA, kfa, 0); SBAR();
        IMMA(accB, kfa, 1); IRED(accA, 0, 0); SBAR();
        if (nq == 4) { IREAD(kfa, 2); asm volatile("s_waitcnt lgkmcnt(8)" ::: "memory"); } else asm volatile("s_waitcnt lgkmcnt(0)" ::: "memory");
        SBAR();
        IMMA(accA, kfb, 0); IRED(accB, 1, 0); SBAR();
        IMMA(accB, kfb, 1); IRED(accA, 0, 1); SBAR();
        if (nq == 4) {
            IREAD(kfb, 3); asm volatile("s_waitcnt lgkmcnt(8)" ::: "memory"); SBAR();
            IMMA(accA, kfa, 0); IRED(accB, 1, 1); SBAR();
            {
                const int j = 2 * J; const bool kv = j * 64 + lane < nvalid;
                s0[j * 64 + lane] = kv ? (hi ? sc[0][1] : sc[0][0]) : -INFINITY;
                s1[j * 64 + lane] = kv ? (hi ? sc[1][1] : sc[1][0]) : -INFINITY;
            }
            IMMA(accB, kfa, 1); IRED(accA, 0, 2); SBAR();
            asm volatile("s_waitcnt lgkmcnt(0)" ::: "memory"); SBAR();
            IMMA(accA, kfb, 0); IRED(accB, 1, 2); SBAR();
            IMMA(accB, kfb, 1); IRED(accA, 0, 3); SBAR();
            IRED(accB, 1, 3);
            const int j = 2 * J + 1; const bool kv = j * 64 + lane < nvalid;
            s0[j * 64 + lane] = kv ? (hi ? sc[0][3] : sc[0][2]) : -INFINITY;
            s1[j * 64 + lane] = kv ? (hi ? sc[1][3] : sc[1][2]) : -INFINITY;
        } else {
            IRED(accB, 1, 1);
            const int j = 2 * J; const bool kv = j * 64 + lane < nvalid;
            s0[j * 64 + lane] = kv ? (hi ? sc[0][1] : sc[0][0]) : -INFINITY;
            s1[j * 64 + lane] = kv ? (hi ? sc[1][1] : sc[1][0]) : -INFINITY;
        }
    }
#undef IMMA
#undef IRED
#undef IREAD
#undef ISTAGE2
    for (int j = NT * 64 + lane; j < (int)spitch; j += 64) { s0[j] = -INFINITY; s1[j] = -INFINITY; }
}

__device__ __forceinline__ unsigned okey(float f) { const unsigned u = __float_as_uint(f); return (u & 0x80000000u) ? ~u : (u | 0x80000000u); }
template <int NS> __device__ __forceinline__ void topk_wave(const float* srow, u64* mrow, int lane) {
    asm volatile("" : "+v"(lane));
    unsigned key[NS];
    {
        unsigned long long base = (unsigned long long)srow;
#pragma unroll
        for (int j0 = 0; j0 < NS; j0 += 16) {
            asm volatile("" : "+s"(base));
            const float* b = (const float*)base + lane;
#pragma unroll
            for (int jj = 0; jj < 16; ++jj) key[j0 + jj] = okey(b[jj * 64]);
            base += 4096;
        }
    }
    unsigned T = 0u; bool exact = false;
    for (int bit = 31; bit >= 0; --bit) {
        const unsigned cand = T | (1u << bit); unsigned tot = 0;
#pragma unroll
        for (int j = 0; j < NS; ++j) { tot += (unsigned)__builtin_popcountll(__ballot(key[j] >= cand)); if ((j & 7) == 7) SBAR(); }
        if (tot >= 256u) T = cand;
        if (tot == 256u) { exact = true; break; }
    }
    T = (unsigned)__builtin_amdgcn_readfirstlane((int)T);
    if (exact) {
        u64* mp = mrow; asm volatile("" : "+v"(mp));
#pragma unroll
        for (int j = 0; j < NS; ++j) { const u64 m = __ballot(key[j] >= T); if (lane == 0) mp[j] = m; if ((j & 3) == 3) SBAR(); }
    } else {
        unsigned gt = 0;
        for (int j = 0; j < NS; ++j) gt += (unsigned)__builtin_popcountll(__ballot(okey(srow[64 * j + lane]) > T));
        int need = 256 - (int)gt;
        for (int j = 0; j < NS; ++j) {
            const unsigned k = okey(srow[64 * j + lane]); const u64 g = __ballot(k > T); u64 e = __ballot(k == T);
            while ((int)__builtin_popcountll(e) > need) e &= ~(1ull << (63 - __builtin_clzll(e)));
            need -= (int)__builtin_popcountll(e);
            if (lane == 0) mrow[j] = g | e;
        }
    }
}
__device__ __forceinline__ void topk_row_wave(const float* srow, int n, int pitch, u64* mrow, int lane) {
    if (n <= 256) { const int nt = (n + 63) >> 6; if (lane < nt) mrow[lane] = ~0ull; return; }
    if (pitch == 1024) topk_wave<16>(srow, mrow, lane);
    else if (pitch == 2048) topk_wave<32>(srow, mrow, lane);
    else if (pitch == 4096) topk_wave<64>(srow, mrow, lane);
    else topk_wave<128>(srow, mrow, lane);
}
#undef SBAR
#undef BAR
}

__device__ const unsigned short IDX_UNITS[512] = {2, 451, 3, 452, 1, 448, 0, 450, 42, 411, 33, 416, 104, 343, 18, 434, 74, 375, 4, 442, 70, 378, 11, 441, 77, 369, 14, 437, 120, 325, 94, 353, 13, 507, 16, 501, 15, 506, 9, 504, 8, 505, 5, 509, 23, 496, 6, 508, 27, 495, 34, 487, 12, 503, 30, 488, 21, 497, 19, 502, 7, 511, 20, 499, 36, 482, 43, 476, 38, 481, 31, 490, 45, 474, 24, 492, 55, 469, 10, 510, 25, 493, 29, 491, 53, 466, 72, 444, 58, 463, 61, 457, 44, 477, 51, 472, 17, 500, 39, 484, 41, 480, 46, 479, 63, 459, 26, 494, 54, 467, 50, 475, 62, 461, 52, 470, 47, 473, 56, 464, 59, 462, 35, 486, 71, 449, 65, 458, 22, 498, 57, 465, 28, 489, 48, 468, 60, 460, 37, 483, 40, 478, 32, 485, 49, 471, 66, 456, 73, 447, 79, 443, 67, 453, 69, 454, 82, 439, 64, 455, 76, 438, 68, 445, 75, 446, 78, 440, 81, 435, 91, 427, 80, 436, 87, 433, 84, 430, 88, 425, 90, 431, 95, 421, 93, 423, 83, 432, 96, 417, 86, 429, 107, 414, 92, 426, 89, 424, 99, 420, 100, 419, 103, 415, 98, 422, 101, 413, 109, 406, 97, 418, 102, 412, 106, 410, 110, 407, 111, 409, 105, 408, 108, 405, 115, 403, 85, 428, 114, 400, 112, 404, 130, 389, 121, 397, 118, 401, 117, 398, 113, 402, 129, 390, 126, 393, 116, 399, 124, 391, 119, 396, 123, 392, 122, 394, 131, 385, 133, 382, 125, 395, 127, 388, 132, 386, 137, 383, 135, 384, 128, 387, 134, 381, 139, 380, 143, 374, 140, 373, 138, 379, 142, 376, 136, 377, 150, 364, 149, 365, 147, 370, 146, 371, 156, 359, 148, 366, 145, 367, 153, 361, 141, 372, 144, 368, 157, 357, 155, 363, 154, 362, 163, 349, 159, 356, 164, 346, 151, 360, 162, 352, 152, 358, 170, 345, 174, 342, 167, 350, 166, 347, 165, 348, 160, 354, 158, 355, 169, 340, 161, 351, 171, 344, 178, 337, 173, 339, 172, 336, 168, 341, 181, 333, 179, 332, 175, 338, 176, 335, 182, 330, 180, 328, 183, 329, 177, 334, 185, 326, 186, 331, 187, 324, 184, 327, 189, 321, 190, 323, 188, 322, 191, 320, 192, 317, 194, 319, 195, 318, 193, 316, 199, 312, 198, 313, 196, 315, 197, 314, 200, 309, 203, 311, 201, 310, 202, 308, 204, 304, 206, 306, 207, 305, 205, 307, 209, 303, 208, 302, 210, 301, 211, 300, 215, 299, 214, 297, 213, 298, 212, 296, 217, 293, 219, 294, 216, 295, 218, 292, 221, 289, 223, 290, 222, 291, 220, 288, 227, 285, 225, 284, 226, 286, 224, 287, 230, 281, 229, 283, 231, 282, 228, 280, 235, 276, 233, 278, 234, 279, 232, 277, 236, 274, 237, 272, 238, 273, 239, 275, 243, 269, 242, 270, 241, 268, 240, 271, 246, 264, 244, 265, 247, 267, 245, 266, 251, 263, 248, 260, 249, 262, 250, 261, 252, 256, 253, 257, 255, 258, 254, 259};
__device__ __forceinline__ void p5_mla_and_indexer(const Ctx& C) {
    unsigned char* ws = C.ws; const int w = C.wave;
    const bf16* QAN = (const bf16*)(ws + WS_QAN); const bf16* QAR = (const bf16*)(ws + WS_QAR); const bf16* KN = (const bf16*)(ws + WS_KN); const bf16* VM = (const bf16*)(ws + WS_VM);
    const bf16* KRP = (const bf16*)(ws + WS_KROPE); const bf16* SGA = (const bf16*)(ws + WS_SGA); bf16* OUTA = (bf16*)(ws + WS_OUTA);
    const bf16* QI = (const bf16*)(ws + WS_QI); const bf16* KI = (const bf16*)(ws + WS_KI); const float* WI = (const float*)(ws + WS_WI); float* SC = (float*)(ws + WS_SCORE);
    for (int v = C.bx; v < 256; v += C.G) {
        const int x = v & 7, jj = v >> 3;
        for (int k = 0; k < 4; ++k) {
            const int h = x + 8 * k, qb = (k & 1) ? 31 - jj : jj;
            att::Desc D; D.K = KN + h * 128; D.ldk = 4096; D.Kr = KRP; D.V = VM + h * 128; D.ldv = 4096; D.NT = 4 * (qb + 1); D.nvis = 4 * qb + (w >> 1) + 1; D.lastmask = ~0ull;
            D.tok0 = 256 * qb + 32 * w; D.tmask = 31; D.hshift = 5; D.hcol0 = h * 128; D.nvalid = 32;
            att::attn_unit<0>(C.lds, D, QAN, QAR, nullptr, SGA, nullptr, OUTA, w, C.lane);
        }
        for (int k = 0; k < 2; ++k) {
            const int su = v + 256 * k, b = su >> 5, h = su & 31; const size_t kr0 = (size_t)SEQ + (size_t)b * SPITCH;
            att::Desc D; D.K = KN + kr0 * 4096 + h * 128; D.ldk = 4096; D.Kr = KRP + kr0 * 64; D.V = VM + kr0 * 4096 + h * 128; D.ldv = 4096; D.NT = 17; D.nvis = (w == 0) ? 17 : 0; D.lastmask = 0xFFFFull;
            D.tok0 = SEQ + 16 * b; D.tmask = 15; D.hshift = 5; D.hcol0 = h * 128; D.nvalid = 16;
            att::attn_unit<0>(C.lds, D, QAN, QAR, nullptr, SGA, nullptr, OUTA, w, C.lane);
        }
    }
    for (int v = C.bx; v < 256; v += C.G) {
        for (int k = 0; k < 2; ++k) {
            const int un = IDX_UNITS[v * 2 + k], c = un >> 2, tg = un & 3; const size_t pitch = (size_t)score_pitch(c);
            att::idx_unit(C.lds, QI, WI, KI, 64 * c + 16 * tg, c + 1, 64 * (c + 1), SC + score_chunk_off(c) + (size_t)(16 * tg) * pitch, pitch, w, C.lane);
        }
        if (v < DEC_B) att::idx_unit(C.lds, QI, WI, KI + ((size_t)SEQ + (size_t)v * SPITCH) * 128, SEQ + 16 * v, 17, SKEYS, SC + SCORE_P_FLOATS + (size_t)(16 * v) * SPITCH_SC, SPITCH_SC, w, C.lane);
    }
    asm volatile("s_waitcnt vmcnt(0) lgkmcnt(0)" ::: "memory"); __syncthreads();
}
__device__ __forceinline__ void p6_topk(const Ctx& C) {
    const float* SC = (const float*)(C.ws + WS_SCORE); att::u64* MASK = (att::u64*)(C.ws + WS_MASK);
    const int gw = C.bx * NWAVES + C.wave, NGW = C.G * NWAVES;
    for (int r = gw; r < NROW; r += NGW) {
        int n, pitch; const float* srow;
        if (r < SEQ) { const int c = r >> 6; n = 64 * (c + 1); pitch = score_pitch(c); srow = SC + score_chunk_off(c) + (size_t)(r & 63) * pitch; }
        else { n = SKEYS; pitch = SPITCH_SC; srow = SC + SCORE_P_FLOATS + (size_t)(r - SEQ) * SPITCH_SC; }
        att::topk_row_wave(srow, n, pitch, MASK + (size_t)r * 128, C.lane);
    }
}
__device__ const unsigned char DSA_CHUNKS[128] = {1, 115, 63, 66, 2, 118, 64, 61, 0, 110, 60, 75, 12, 104, 62, 68, 3, 119, 57, 67, 13, 102, 58, 73, 6, 124, 56, 59, 8, 100, 65, 72, 7, 117, 52, 69, 9, 114, 53, 70, 5, 123, 46, 71, 4, 126, 38, 77, 11, 105, 55, 74, 15, 107, 42, 81, 14, 103, 49, 80, 16, 96, 54, 79, 10, 120, 51, 82, 17, 121, 48, 76, 18, 111, 50, 84, 19, 127, 31, 86, 25, 116, 44, 78, 20, 125, 29, 89, 22, 113, 41, 87, 23, 112, 43, 85, 21, 109, 37, 95, 28, 122, 30, 83, 26, 99, 45, 92, 24, 101, 47, 91, 27, 108, 35, 93, 39, 97, 33, 94, 32, 106, 36, 88, 40, 98, 34, 90};
__device__ __forceinline__ void p7_dsa(const Ctx& C) {
    unsigned char* ws = C.ws; const int w = C.wave;
    const bf16* QB = (const bf16*)(ws + WS_QB); const bf16* KA = (const bf16*)(ws + WS_KALL); const bf16* VA = (const bf16*)(ws + WS_VALL);
    const att::u64* MASK = (const att::u64*)(ws + WS_MASK); const bf16* SGB = (const bf16*)(ws + WS_SGB); const bf16* OUTA = (const bf16*)(ws + WS_OUTA); bf16* MG = (bf16*)(ws + WS_MERGED);
    for (int v = C.bx; v < 256; v += C.G) {
        const int g = v & 7, jj = v >> 3;
        for (int k = 0; k < 4; ++k) {
            const int c = DSA_CHUNKS[jj * 4 + k];
            att::Desc D; D.K = KA + g * 128; D.ldk = 1024; D.Kr = nullptr; D.V = VA + g * 128; D.ldv = 1024; D.NT = c + 1; D.nvis = c + 1; D.lastmask = ~0ull;
            D.tok0 = 64 * c + 32 * (w & 1); D.tmask = 31; D.hshift = 5; D.hcol0 = (4 * g + (w >> 1)) * 128; D.nvalid = 32;
            att::attn_unit<1>(C.lds, D, QB, nullptr, MASK, SGB, OUTA, MG, w, C.lane);
        }
        if (v < DEC_B * NKV) {
            const int b = v >> 3; const size_t kr0 = (size_t)SEQ + (size_t)b * SPITCH;
            att::Desc D; D.K = KA + kr0 * 1024 + g * 128; D.ldk = 1024; D.Kr = nullptr; D.V = VA + kr0 * 1024 + g * 128; D.ldv = 1024; D.NT = 17; D.nvis = (w < 2) ? 17 : 0; D.lastmask = ~0ull;
            D.tok0 = SEQ + 16 * b; D.tmask = 15; D.hshift = 4; D.hcol0 = (4 * g + 2 * w) * 128; D.nvalid = 32;
            att::attn_unit<1>(C.lds, D, QB, nullptr, MASK, SGB, OUTA, MG, w, C.lane);
        }
    }
    asm volatile("s_waitcnt vmcnt(0) lgkmcnt(0)" ::: "memory"); __syncthreads();
}


constexpr int N_PHASES = 13;
__global__ void __launch_bounds__(NWAVES * 64, 2) fwd_kernel(Args args) {
    extern __shared__ __attribute__((aligned(16))) unsigned char lds_raw[];
    Ctx C; C.lds = (LAS unsigned char*)lds_raw; C.a = &args; C.ws = args.ws; C.out = args.out;
    C.tid = threadIdx.x; C.lane = C.tid & 63; C.wave = __builtin_amdgcn_readfirstlane(C.tid >> 6); C.G = gridDim.x; C.bx = blockIdx.x;
    volatile LAS unsigned* MISC = (volatile LAS unsigned*)(C.lds + MISC_OFF);
    for (int u = C.tid; u < (LDS_BYTES - LDSCTL_OFF) / 4; u += NWAVES * 64) ((LAS unsigned*)(C.lds + LDSCTL_OFF))[u] = 0u;
    __syncthreads();
    unsigned* ctl = (unsigned*)(args.ws + WS_CTL);
    XcdBarrier bar; bar.bar = ctl + CW_BAR; bar.x = 0; bar.st = nullptr;
    if (MK_N_LAUNCHES == 1) bar = xcd_barrier_post(ctl + CW_BAR, MISC + 8);
    const int lo = args.ph_lo, hi = args.ph_hi;
#ifndef PH_MASK
#define PH_MASK 0xFFFFFFFFu
#endif
#define IN(k) (((PH_MASK >> (k)) & 1) && lo <= (k) && (k) < hi)
#define SEAM(k) do { if (IN(k) && IN((k) + 1)) xcd_barrier(bar); } while (0)
    unsigned char* ws = args.ws;
    PG8_LAS unsigned char* ring = (PG8_LAS unsigned char*)lds_raw;

    if (IN(0)) { p01_gemv_and_copies(C); SEAM(0); }
    if (IN(1)) { p1_modnorm(C); SEAM(1); }
    if (IN(2)) {
        pg8::Gemm g{(const pg8::bf16_t*)(ws + WS_XN), (const pg8::bf16_t*)(ws + WS_WIN), NROW, DINP, DM}; pg8::StaticOrder S; S.init(NROW, DINP, C.G, C.bx);
        const float* rp = (const float*)(ws + WS_ROPE);
        pg8::EpiIn E{(float*)(ws + WS_QRAW), (float*)(ws + WS_CKVRAW), (pg8::bf16_t*)(ws + WS_QB), (pg8::bf16_t*)(ws + WS_QI), (pg8::bf16_t*)(ws + WS_SGA), (pg8::bf16_t*)(ws + WS_SGB),
                     (pg8::bf16_t*)(ws + WS_KALL), (pg8::bf16_t*)(ws + WS_VALL), (pg8::bf16_t*)(ws + WS_KI), (pg8::bf16_t*)(ws + WS_KROPE), (float*)(ws + WS_WI), args.out,
                     rp, rp + SEQ * 32, rp + SEQ * 64, rp + SEQ * 64 + SEQ * 16};
        S.lim = (S.nwg / C.G) * C.G;
        pg8::gemm_phase<pg8::EpiIn, pg8::StaticOrder, true, true>(ring, g, S, E);
        { pg8::TailHalfOrder T; T.init(NROW, DINP, C.G, C.bx); pg8::gemm_phase<pg8::EpiIn, pg8::TailHalfOrder, true, true, true>(ring, g, T, E); }
        SEAM(2);
    }
    if (IN(3)) { p3_norms(C); SEAM(3); }
    if (IN(4)) {
        {
            pg8::Gemm g{(const pg8::bf16_t*)(ws + WS_QN), (const pg8::bf16_t*)(ws + WS_WUQ), NROW, 6144, QLORA}; pg8::StaticOrder S; S.init(NROW, 6144, C.G, C.bx);
            const float* rp = (const float*)(ws + WS_ROPE);
            pg8::EpiUq E{(pg8::bf16_t*)(ws + WS_QAN), (pg8::bf16_t*)(ws + WS_QAR), rp, rp + SEQ * 32};
            pg8::gemm_phase<pg8::EpiUq, pg8::StaticOrder, true, true>(ring, g, S, E);
        }
        {
            pg8::Gemm g{(const pg8::bf16_t*)(ws + WS_CKV), (const pg8::bf16_t*)(ws + WS_WUKV), KROWS, 8192, KVLORA}; pg8::StaticOrder S; S.init(KROWS, 8192, C.G, (C.bx + C.G / 2) % C.G);
            pg8::EpiBf16<0> E{(pg8::bf16_t*)(ws + WS_KN), 4096, 4096, (WS_VM - WS_KN) / 2};
            pg8::gemm_phase<pg8::EpiBf16<0>, pg8::StaticOrder, true, true>(ring, g, S, E);
        }
        SEAM(4);
    }
    if (IN(5)) { p5_mla_and_indexer(C); SEAM(5); }
    if (IN(6)) { p6_topk(C); SEAM(6); }
    if (IN(7)) { p7_dsa(C); SEAM(7); }
    if (IN(8)) {
        pg8::Gemm g{(const pg8::bf16_t*)(ws + WS_MERGED), (const pg8::bf16_t*)(ws + WS_WOUT), NROW, DM, DM}; pg8::SampleSplitOrder S; S.init(SEQ, DM, DM, SPLIT_OUT, C.G, C.bx);
        pg8::EpiRes E{args.in[I_XP], args.in[I_XS], args.out + O_Y, (const float*)(ws + WS_ADA) + 2 * DM, (float*)(ws + WS_SLAB)};
        pg8::gemm_phase<pg8::EpiRes, pg8::SampleSplitOrder, true, true>(ring, g, S, E);
        SEAM(8);
    }
    if (IN(9)) { p9_h2(C); SEAM(9); }
    if (IN(10)) {
        pg8::Gemm g{(const pg8::bf16_t*)(ws + WS_XN), (const pg8::bf16_t*)(ws + WS_WUP), NROW, DFF, DM}; pg8::StaticOrder S; S.init(NROW, DFF, C.G, C.bx);
        pg8::EpiBf16<2> E{(pg8::bf16_t*)(ws + WS_U), DFF, 0, 0};
        S.lim = (S.nwg / C.G) * C.G;
        pg8::gemm_phase<pg8::EpiBf16<2>, pg8::StaticOrder, true, true>(ring, g, S, E);
        { pg8::TailHalfOrder T; T.init(NROW, DFF, C.G, C.bx); pg8::gemm_phase<pg8::EpiBf16<2>, pg8::TailHalfOrder, true, true, true>(ring, g, T, E); }
        SEAM(10);
    }
    if (IN(11)) {
        pg8::Gemm g{(const pg8::bf16_t*)(ws + WS_U), (const pg8::bf16_t*)(ws + WS_WDOWN), NROW, DM, DFF}; pg8::SampleSplitOrder S; S.init(SEQ, DM, DFF, SPLIT_DOWN, C.G, C.bx);
        pg8::EpiRes E{args.out + O_Y, args.out + O_Y + (size_t)SEQ * DM, args.out + O_Y, (const float*)(ws + WS_ADA) + 5 * DM, (float*)(ws + WS_SLAB)};
        pg8::gemm_phase<pg8::EpiRes, pg8::SampleSplitOrder, true, true>(ring, g, S, E);
        SEAM(11);
    }
    if (IN(12)) { p12_final(C); }
#undef IN
#undef SEAM
}

extern "C" void kernel_launch(void* const* d_in, const int* in_sizes, int n_in, void* d_out, int out_size, void* d_ws, size_t ws_size, hipStream_t stream) {
    static int grid = 0;
    if (grid == 0) {
        if (n_in != N_IN || in_sizes[I_XP] != SEQ * DM || in_sizes[I_WIN] != DM * DIN || (size_t)out_size != O_END || ws_size < WS_END) {
            fprintf(stderr, "kernel_launch: shape mismatch (n_in %d, out %d, ws %zu, need ws >= %zu); nothing launched\n", n_in, out_size, ws_size, (size_t)WS_END); grid = -1; return; }
        int dev = 0, cus = 0, per_cu = 0;
        if (hipGetDevice(&dev) != hipSuccess || hipDeviceGetAttribute(&cus, hipDeviceAttributeMultiprocessorCount, dev) != hipSuccess) { grid = -1; return; }
        if (hipFuncSetAttribute((const void*)fwd_kernel, hipFuncAttributeMaxDynamicSharedMemorySize, LDS_BYTES) != hipSuccess) { fprintf(stderr, "kernel_launch: hipFuncSetAttribute failed\n"); grid = -1; return; }
        if (hipOccupancyMaxActiveBlocksPerMultiprocessor(&per_cu, (const void*)fwd_kernel, NWAVES * 64, LDS_BYTES) != hipSuccess || per_cu < 1) { fprintf(stderr, "kernel_launch: occupancy query says %d\n", per_cu); }
        (void)hipGetLastError();
        grid = cus;
    }
    if (grid < 0) return;
    (void)hipMemsetAsync((char*)d_ws + WS_CTL, 0, CTL_ZERO_BYTES, stream);
    Args a{};
    for (int i = 0; i < N_IN; ++i) a.in[i] = (const float*)d_in[i];
    a.out = (float*)d_out; a.ws = (unsigned char*)d_ws;
    if (MK_N_LAUNCHES == 1) { a.ph_lo = 0; a.ph_hi = N_PHASES; a.li = 0; hipLaunchKernelGGL(fwd_kernel, dim3(grid), dim3(NWAVES * 64), LDS_BYTES, stream, a); }
    else {
        const int order[13] = {0, 1, 2, 3, 4, 5, 6, 7, 8, 9, 10, 11, 12};
        for (int q = 0; q < N_PHASES; ++q) { const int p = order[q]; a.ph_lo = p; a.ph_hi = p + 1; a.li = p; hipLaunchKernelGGL(fwd_kernel, dim3(grid), dim3(NWAVES * 64), LDS_BYTES, stream, a); }
    }
    const hipError_t le = hipPeekAtLastError();
    if (le != hipSuccess) fprintf(stderr, "kernel_launch: launch failed: %s\n", hipGetErrorName(le));
}
```

```cpp
#include <hip/hip_runtime.h>
#include <cstdio>
#include <cstdint>

#ifndef MK_N_LAUNCHES
#define MK_N_LAUNCHES 1
#endif

constexpr int DM = 4096, SEQ = 8192, NSAMP = 256, NROW = SEQ + NSAMP;
constexpr int DEC_B = 16, DEC_S = 16, PAST = 1024, SKEYS = PAST + DEC_S, SPITCH = 1088;
constexpr int KROWS = SEQ + DEC_B * SPITCH;
constexpr int DIN = 20192, DINP = 20224, DFF = 16384, NADA = 6 * DM, NVEC = 1 + DEC_B;
constexpr int NH = 32, QLORA = 1024, KVLORA = 512, ROPE_M = 64, NKV = 8;
constexpr float EPS = 1e-6f;
constexpr float LOG2E = 1.4426950408889634f;
constexpr float C_MLA = 0.07216878364870322f * LOG2E;
constexpr float C_DSA = 0.08838834764831845f * LOG2E;
constexpr float IDX_W_SCALE = 0.17677669529663687f;

enum { I_XP = 0, I_XS, I_CP, I_CS, I_CCKV, I_CKROPE, I_CK, I_CV, I_CKI, I_WADA, I_BADA, I_G1, I_WIN, I_GQ, I_WUQ, I_GKV, I_WUK, I_WUV, I_WOUT, I_G2, I_WUP, I_WDOWN, I_GF, N_IN };
constexpr size_t O_Y = 0, O_CKV_P = 34603008, O_KROPE_P = 38797312, O_K_P = 39321600, O_V_P = 47710208, O_KI_P = 56098816,
                 O_CKV_S = 57147392, O_KROPE_S = 57278464, O_K_S = 57294848, O_V_S = 57556992, O_KI_S = 57819136, O_END = 57851904;

constexpr size_t MiB = 1u << 20;
constexpr size_t WS_CTL = 0, CTL_ZERO_BYTES = 4 * MiB;
constexpr size_t WS_ADA = 1 * MiB;
constexpr size_t WS_ROPE = 4 * MiB;
constexpr size_t WS_WI = 7 * MiB;
constexpr size_t WS_MASK = 9 * MiB;
constexpr size_t WS_WOUT = 18 * MiB, WS_WUP = 50 * MiB, WS_WDOWN = 178 * MiB, WS_WIN = 306 * MiB, WS_WUQ = 464 * MiB, WS_WUKV = 476 * MiB;
constexpr size_t WS_QN = WS_WIN, WS_QAN = WS_WIN + 17 * MiB, WS_QAR = WS_WIN + 83 * MiB;
constexpr size_t WS_XN = 484 * MiB;
constexpr size_t WS_CKV = 550 * MiB, WS_KROPE = 575 * MiB, WS_KALL = 579 * MiB, WS_VALL = 629 * MiB, WS_KI = 679 * MiB;
constexpr size_t WS_QB = 686 * MiB, WS_QI = 752 * MiB, WS_SGA = 818 * MiB, WS_SGB = 884 * MiB;
constexpr size_t WS_MERGED = WS_QI;
constexpr size_t WS_KN = 950 * MiB, WS_VM = 1150 * MiB;
constexpr size_t WS_U = WS_KN;
constexpr size_t WS_SLAB = WS_VM + 64 * MiB;
constexpr int SPLIT_OUT = 8, SPLIT_DOWN = 16;
constexpr size_t WS_OUTA = 1350 * MiB;
constexpr size_t WS_QRAW = 1416 * MiB, WS_CKVRAW = 1449 * MiB;
constexpr size_t WS_SCORE = WS_QRAW;
__host__ __device__ constexpr int score_pitch(int c) { return c < 16 ? 1024 : c < 32 ? 2048 : c < 64 ? 4096 : 8192; }
__host__ __device__ constexpr size_t score_chunk_off(int c) { return c < 16 ? (size_t)c * 65536 : c < 32 ? (size_t)1048576 + (size_t)(c - 16) * 131072 : c < 64 ? (size_t)3145728 + (size_t)(c - 32) * 262144 : (size_t)11534336 + (size_t)(c - 64) * 524288; }
constexpr size_t SCORE_P_FLOATS = score_chunk_off(128);
constexpr int SPITCH_SC = 2048;
constexpr size_t WS_END = WS_SCORE + (SCORE_P_FLOATS + (size_t)NSAMP * SPITCH_SC) * 4;
static_assert(WS_WIN + (size_t)DINP * DM * 2 <= WS_WUQ && WS_QAR + (size_t)NROW * 2048 * 2 <= WS_WUQ, "ws map 1");
static_assert(WS_KN + (size_t)KROWS * 4096 * 2 <= WS_VM && WS_VM + (size_t)KROWS * 4096 * 2 <= WS_OUTA && WS_U + (size_t)NROW * DFF * 2 <= WS_OUTA, "ws map 2");
static_assert(WS_MASK + (size_t)NROW * 128 * 8 <= WS_WOUT && WS_ADA + (size_t)NVEC * NADA * 4 <= CTL_ZERO_BYTES, "ws map 3");
constexpr int CW_TMO = 0, CW_BAR = 4096;

constexpr int RING_BYTES = 131072;
constexpr int LDSCTL_OFF = RING_BYTES, MISC_OFF = LDSCTL_OFF + 320;
constexpr int LDS_BYTES = 147456;

#define GAS __attribute__((address_space(1)))
#define LAS __attribute__((address_space(3)))
typedef unsigned short bf16;
typedef unsigned v4u __attribute__((ext_vector_type(4)));
typedef unsigned v2u __attribute__((ext_vector_type(2)));
typedef float v4f __attribute__((ext_vector_type(4)));
typedef GAS unsigned gu32;
#define RLX_AGENT __ATOMIC_RELAXED, __HIP_MEMORY_SCOPE_AGENT
#define LDS_WAIT() asm volatile("s_waitcnt lgkmcnt(0)" ::: "memory")
#define VM_WAIT() asm volatile("s_waitcnt vmcnt(0)" ::: "memory")
__device__ __forceinline__ unsigned f2bf(float f) { unsigned u = __builtin_bit_cast(unsigned, f); return (u + 0x7fffu + ((u >> 16) & 1u)) >> 16; }
__device__ __forceinline__ unsigned pk2(float lo, float hi) { return f2bf(lo) | (f2bf(hi) << 16); }
__device__ __forceinline__ float bf2f(unsigned short b) { return __builtin_bit_cast(float, (unsigned)b << 16); }
__device__ __forceinline__ float wave_sum(float v) {
#pragma unroll
    for (int o = 1; o < 64; o <<= 1) v += __shfl_xor(v, o);
    return v;
}
__device__ __forceinline__ int row_vec(int r) { return r < SEQ ? 0 : 1 + ((r - SEQ) >> 4); }
__device__ __forceinline__ int row_key(int r) { return r < SEQ ? r : SEQ + ((r - SEQ) >> 4) * SPITCH + PAST + (r & 15); }
__device__ __forceinline__ int row_pos(int r) { return r < SEQ ? r : PAST + (r & 15); }

namespace pg8 {
#define PG8_LAS __attribute__((address_space(3)))
typedef unsigned short bf16_t;
typedef short bf16x8 __attribute__((ext_vector_type(8)));
typedef float f32x4 __attribute__((ext_vector_type(4)));
typedef unsigned u32x4 __attribute__((ext_vector_type(4)));
constexpr int BM = 256, BK = 64, HALF = 128, HTB = HALF * BK * 2  , STAGE_BYTES = 8 * HTB, NXCD = 8, WGM = 8;

__host__ __device__ __forceinline__ int lds_byte(int r, int c) { const int st = (r >> 4) * 2 + (c >> 5), rr = r & 15, cc = c & 31, ob = rr * 64 + cc * 2; return st * 1024 + (ob ^ (((ob >> 9) & 1) << 5)); }
__host__ __device__ __forceinline__ void stage_rc(int b, int& R, int& C) { const int st = b / 1024, sb = b % 1024, swz = sb ^ (((sb >> 9) & 1) << 5); R = (st >> 1) * 16 + swz / 64; C = (st & 1) * 32 + (swz % 64) / 2; }
__host__ __device__ __forceinline__ int perm32(int rho) { const int n = rho >> 4, i = rho & 15; return 8 * (i >> 2) + 4 * n + (i & 3); }

struct Unit { int pm, pn, k0, nt, sp, hf; };
struct Gemm { const bf16_t* A; const bf16_t* Bt; int M, N, K; };

struct StaticOrder {
    int nM, nN, nwg, G, c, lim;
    __host__ __device__ void init(int M, int N, int G_, int c_) { nM = M / BM; nN = N / BM; nwg = nM * nN; G = G_; c = c_; lim = nwg; }
    __host__ __device__ __forceinline__ bool next(int i, Unit& u) const {
        const long L = (long)i * G + c; if (L >= lim) return false;
        int wgid = (int)L; { const int q = nwg / NXCD, r = nwg % NXCD, xcd = wgid % NXCD, off = wgid / NXCD; wgid = (xcd < r ? xcd * (q + 1) : r * (q + 1) + (xcd - r) * q) + off; }
        const int nig = WGM * nN, gid = wgid / nig, fm = gid * WGM, gsz = (nM - fm) < WGM ? (nM - fm) : WGM;
        u.pm = fm + ((wgid % nig) % gsz); u.pn = (wgid % nig) / gsz; u.k0 = 0; u.nt = 0; u.sp = -1; u.hf = 0; return true;
    }
    __device__ __forceinline__ void a_ready(const Unit&) const {}
    __device__ __forceinline__ void done(const Unit&) const {}
};

struct TailHalfOrder {
    int nM, nN, nwg, G, c, nfull;
    __host__ __device__ void init(int M, int N, int G_, int c_) { nM = M / BM; nN = N / BM; nwg = nM * nN; G = G_; c = c_; nfull = (nwg / G) * G; }
    __host__ __device__ __forceinline__ bool next(int i, Unit& u) const {
        const long s_ = (long)i * G + c; if (s_ >= 2L * (nwg - nfull)) return false;
        int wgid = nfull + (int)(s_ >> 1); { const int q = nwg / NXCD, r = nwg % NXCD, xcd = wgid % NXCD, off = wgid / NXCD; wgid = (xcd < r ? xcd * (q + 1) : r * (q + 1) + (xcd - r) * q) + off; }
        const int nig = WGM * nN, gid = wgid / nig, fm = gid * WGM, gsz = (nM - fm) < WGM ? (nM - fm) : WGM;
        u.pm = fm + ((wgid % nig) % gsz); u.pn = (wgid % nig) / gsz; u.k0 = 0; u.nt = 0; u.sp = -1; u.hf = (int)(s_ & 1); return true;
    }
    __device__ __forceinline__ void a_ready(const Unit&) const {}
    __device__ __forceinline__ void done(const Unit&) const {}
};

struct SampleSplitOrder {
    int nMp, nN, nwg, S, ntk, G, c;
    __host__ __device__ void init(int Mp, int N, int K, int S_, int G_, int c_) { nMp = Mp / BM; nN = N / BM; nwg = nMp * nN; S = S_; ntk = K / BK; G = G_; c = c_; }
    __host__ __device__ __forceinline__ bool next(int i, Unit& u) const {
        const long L = (long)i * G + c; int pm, pn, k0 = 0, nt = 0, sp = -1; bool ok = true;
        if (L < nwg) {
            int wgid = (int)L; { const int q = nwg / NXCD, r = nwg % NXCD, xcd = wgid % NXCD, off = wgid / NXCD; wgid = (xcd < r ? xcd * (q + 1) : r * (q + 1) + (xcd - r) * q) + off; }
            const int nig = WGM * nN, gid = wgid / nig, fm = gid * WGM, gsz = (nMp - fm) < WGM ? (nMp - fm) : WGM;
            pm = fm + ((wgid % nig) % gsz); pn = (wgid % nig) / gsz;
        } else {
            const int s = (int)(L - nwg); ok = s < nN * S; sp = s / nN; pn = s - sp * nN; pm = nMp; nt = ntk / S; k0 = sp * nt * BK;
        }
        u.pm = pm; u.pn = pn; u.k0 = k0; u.nt = nt; u.sp = sp; u.hf = 0; return ok;
    }
    __device__ __forceinline__ void a_ready(const Unit&) const {}
    __device__ __forceinline__ void done(const Unit&) const {}
};
typedef float cvt_f32x2_t __attribute__((ext_vector_type(2))); typedef __bf16 cvt_bf16x2_t __attribute__((ext_vector_type(2)));
__device__ __forceinline__ unsigned cvt_pk_bf16(float lo, float hi) { cvt_f32x2_t v = {lo, hi}; cvt_bf16x2_t b = __builtin_convertvector(v, cvt_bf16x2_t); return __builtin_bit_cast(unsigned, b); }

typedef float f32x2 __attribute__((ext_vector_type(2)));
typedef unsigned u32x2 __attribute__((ext_vector_type(2)));
__device__ __forceinline__ u32x2 pack4(f32x4 v) { u32x2 w; w.x = cvt_pk_bf16(v[0], v[1]); w.y = cvt_pk_bf16(v[2], v[3]); return w; }
__device__ __forceinline__ void rope4(f32x4& x1, f32x4& x2, const f32x4 c, const f32x4 s) { const f32x4 a = x1 * c - x2 * s, b = x2 * c + x1 * s; x1 = a; x2 = b; }
__device__ __forceinline__ f32x4 sigmoid4(f32x4 v) { f32x4 o;
#pragma unroll
    for (int e = 0; e < 4; ++e) o[e] = __builtin_amdgcn_rcpf(1.0f + __builtin_amdgcn_exp2f(-1.4426950408889634f * v[e]));
    return o; }

struct RowStage {
    PG8_LAS unsigned char* grp; unsigned roff0, roff1;
    __device__ __forceinline__ void init(PG8_LAS unsigned char* stg, int wr, int wc, int lane) {
        grp = stg + wr * 8192; const int rr0 = 4 * wc + (lane >> 5), c = lane & 31;
        roff0 = (unsigned)rr0 * 512u + ((unsigned)((c & 16) | ((c ^ rr0) & 15)) << 4); roff1 = (unsigned)(rr0 + 2) * 512u + ((unsigned)((c & 16) | ((c ^ (rr0 + 2)) & 15)) << 4);
    }
    static __device__ __forceinline__ unsigned woff(int fr, int ch8) { const int c16 = ch8 >> 1; return (unsigned)fr * 512u + ((unsigned)((c16 & 16) | ((c16 ^ fr) & 15)) << 4) + (unsigned)(ch8 & 1) * 8u; }
    __device__ __forceinline__ void step(bool first, const unsigned (&wo)[4], const u32x2 (&p)[4], bf16_t* o, size_t ldc) const {
        if (!first) __builtin_amdgcn_s_barrier();
#pragma unroll
        for (int k = 0; k < 4; ++k) *(PG8_LAS u32x2*)(grp + wo[k]) = p[k];
        asm volatile("s_waitcnt lgkmcnt(0)" ::: "memory"); __builtin_amdgcn_s_barrier();
        const u32x4 r0 = *(const PG8_LAS u32x4*)(grp + roff0), r1 = *(const PG8_LAS u32x4*)(grp + roff1);
        asm volatile("s_waitcnt lgkmcnt(0)" ::: "memory");
        *(u32x4*)o = r0; *(u32x4*)(o + 2 * ldc) = r1;
    }
};

template <int ACT> struct EpiBf16 {
    static constexpr bool PERM = true, AFTER_DRAIN = false, STAGED = true;
    bf16_t* O; int ldc; int split_cols; size_t split_stride;
    template <bool HU> __device__ __forceinline__ void run(const f32x4 (&acc)[2][2][4][2], const Unit& u, int wr, int wc, int fr, int fq) const {
        const int row0 = u.pm * BM + wr * 64 + fr; int colt = u.pn * BM; bf16_t* base = O;
        if (split_cols) { const int t = colt / split_cols; base += (size_t)t * split_stride; colt -= t * split_cols; }
        const int col0 = colt + wc * 32 + 8 * fq;
#pragma unroll
        for (int ai = 0; ai < 2; ++ai)
#pragma unroll
            for (int m = 0; m < 4; ++m) { bf16_t* rowp = base + (size_t)(row0 + ai * HALF + m * 16) * ldc + col0;
#pragma unroll
                for (int bj = 0; bj < 2; ++bj) { f32x4 v0 = acc[ai][bj][m][0], v1 = acc[ai][bj][m][1];
                    if (ACT == 2) {
#pragma unroll
                        for (int e = 0; e < 4; ++e) { const float a = __builtin_amdgcn_fmed3f(v0[e], 0.f, 3.0e38f), b = __builtin_amdgcn_fmed3f(v1[e], 0.f, 3.0e38f); v0[e] = a * a; v1[e] = b * b; } }
                    u32x4 w; w.x = cvt_pk_bf16(v0[0], v0[1]); w.y = cvt_pk_bf16(v0[2], v0[3]); w.z = cvt_pk_bf16(v1[0], v1[1]); w.w = cvt_pk_bf16(v1[2], v1[3]);
                    *(u32x4*)(rowp + bj * HALF) = w; } }
    }
    template <bool HU> __device__ __forceinline__ void staged(const f32x4 (&acc)[2][2][4][2], const Unit& u, int wr, int wc, int fr, int fq, PG8_LAS unsigned char* stg, int lane) const {
        int colt = u.pn * BM; bf16_t* base = O;
        if (split_cols) { const int t = colt / split_cols; base += (size_t)t * split_stride; colt -= t * split_cols; }
        PG8_LAS unsigned char* grp = stg + wr * 8192;
        const unsigned woff = (unsigned)fr * 512u + ((((unsigned)(4 * wc + fq)) ^ (unsigned)fr) << 4);
        const int rr0 = 4 * wc + (lane >> 5), c = lane & 31;
        const unsigned roff0 = (unsigned)rr0 * 512u + ((unsigned)((c & 16) | ((c ^ rr0) & 15)) << 4), roff1 = (unsigned)(rr0 + 2) * 512u + ((unsigned)((c & 16) | ((c ^ (rr0 + 2)) & 15)) << 4);
        bf16_t* gp = base + (size_t)(u.pm * BM + (HU && u.hf ? HALF : 0) + wr * 64 + rr0) * ldc + colt + c * 8;
#pragma unroll
        for (int ai = 0; ai < (HU ? 1 : 2); ++ai)
#pragma unroll
            for (int m = 0; m < 4; ++m) {
                u32x4 w[2];
#pragma unroll
                for (int bj = 0; bj < 2; ++bj) { f32x4 v0 = acc[ai][bj][m][0], v1 = acc[ai][bj][m][1];
                    if (ACT == 2) {
#pragma unroll
                        for (int e = 0; e < 4; ++e) { const float a = __builtin_amdgcn_fmed3f(v0[e], 0.f, 3.0e38f), b = __builtin_amdgcn_fmed3f(v1[e], 0.f, 3.0e38f); v0[e] = a * a; v1[e] = b * b; } }
                    w[bj].x = cvt_pk_bf16(v0[0], v0[1]); w[bj].y = cvt_pk_bf16(v0[2], v0[3]); w[bj].z = cvt_pk_bf16(v1[0], v1[1]); w[bj].w = cvt_pk_bf16(v1[2], v1[3]); }
                if (ai | m) __builtin_amdgcn_s_barrier();
                *(PG8_LAS u32x4*)(grp + woff) = w[0]; *(PG8_LAS u32x4*)(grp + woff + 256) = w[1];
                asm volatile("s_waitcnt lgkmcnt(0)" ::: "memory"); __builtin_amdgcn_s_barrier();
                const u32x4 r0 = *(const PG8_LAS u32x4*)(grp + roff0), r1 = *(const PG8_LAS u32x4*)(grp + roff1);
                asm volatile("s_waitcnt lgkmcnt(0)" ::: "memory");
                bf16_t* o = gp + (size_t)(ai * HALF + m * 16) * ldc;
                *(u32x4*)o = r0; *(u32x4*)(o + (size_t)2 * ldc) = r1;
            }
        __builtin_amdgcn_s_barrier();
    }
};

struct EpiIn {
    static constexpr bool PERM = false, AFTER_DRAIN = false, STAGED = true;
    float* qraw; float* ckvraw; bf16_t* qb; bf16_t* qi; bf16_t* sga; bf16_t* sgb;
    bf16_t* kall; bf16_t* vall; bf16_t* kiall; bf16_t* kropeall; float* wi; float* out;
    const float* cos_m; const float* sin_m; const float* cos_d; const float* sin_d;
    template <bool HU> __device__ __forceinline__ void run(const f32x4 (&acc)[2][2][4][2], const Unit& u, int wr, int wc, int fr, int fq) const {
        const int pn = u.pn; const bool samp = (u.pm == SEQ / BM); const int rb = u.pm * BM + (HU && u.hf ? HALF : 0);
#pragma unroll
        for (int ai = 0; ai < (HU ? 1 : 2); ++ai)
#pragma unroll
            for (int m = 0; m < 4; ++m) {
                const int r = rb + ai * HALF + wr * 64 + m * 16 + fr;
                const int ro = samp ? r - SEQ : r;
                const int kr = row_key(r), pos = row_pos(r);
                if (pn < 4) {
#pragma unroll
                    for (int bj = 0; bj < 2; ++bj)
#pragma unroll
                        for (int n = 0; n < 2; ++n) *(f32x4*)(qraw + (size_t)r * QLORA + pn * BM + bj * HALF + wc * 32 + n * 16 + 4 * fq) = acc[ai][bj][m][n];
                } else if (pn < 6) {
#pragma unroll
                    for (int bj = 0; bj < 2; ++bj)
#pragma unroll
                        for (int n = 0; n < 2; ++n) *(f32x4*)(ckvraw + (size_t)r * KVLORA + (pn - 4) * BM + bj * HALF + wc * 32 + n * 16 + 4 * fq) = acc[ai][bj][m][n];
                } else if (pn < 78) {
                    const int kind = pn < 22 ? 0 : pn < 26 ? 1 : pn < 30 ? 2 : pn < 46 ? 3 : pn < 62 ? 4 : 5;
                    const int t0 = kind == 0 ? 6 : kind == 1 ? 22 : kind == 2 ? 26 : kind == 3 ? 30 : kind == 4 ? 46 : 62;
                    const bool roped = (kind == 0 || kind == 1 || kind == 3);
                    f32x4 cs = {0.f, 0.f, 0.f, 0.f}, sn = cs;
                    if (roped && wc == 0) { cs = *(const f32x4*)(cos_d + pos * 16 + 4 * fq); sn = *(const f32x4*)(sin_d + pos * 16 + 4 * fq); }
#pragma unroll
                    for (int bj = 0; bj < 2; ++bj) {
                        f32x4 v0 = acc[ai][bj][m][0], v1 = acc[ai][bj][m][1];
                        if (roped && wc == 0) rope4(v0, v1, cs, sn);
                        const int c0 = (pn - t0) * BM + bj * HALF + wc * 32 + 4 * fq;
                        if (kind == 0) { *(u32x2*)(qb + (size_t)r * DM + c0) = pack4(v0 * C_DSA); *(u32x2*)(qb + (size_t)r * DM + c0 + 16) = pack4(v1 * C_DSA); }
                        else if (kind == 3) { *(u32x2*)(qi + (size_t)r * DM + c0) = pack4(v0); *(u32x2*)(qi + (size_t)r * DM + c0 + 16) = pack4(v1); }
                        else if (kind == 4) { *(u32x2*)(sga + (size_t)r * DM + c0) = pack4(sigmoid4(v0)); *(u32x2*)(sga + (size_t)r * DM + c0 + 16) = pack4(sigmoid4(v1)); }
                        else if (kind == 5) { *(u32x2*)(sgb + (size_t)r * DM + c0) = pack4(sigmoid4(v0)); *(u32x2*)(sgb + (size_t)r * DM + c0 + 16) = pack4(sigmoid4(v1)); }
                        else {
                            float* o = out + (kind == 1 ? (samp ? O_K_S : O_K_P) : (samp ? O_V_S : O_V_P)) + (size_t)ro * 1024 + c0;
                            *(f32x4*)o = v0; *(f32x4*)(o + 16) = v1;
                            bf16_t* kb = (kind == 1 ? kall : vall) + (size_t)kr * 1024 + c0;
                            *(u32x2*)kb = pack4(v0); *(u32x2*)(kb + 16) = pack4(v1);
                        }
                    }
                } else {
                    {
                        f32x4 v0 = acc[ai][0][m][0], v1 = acc[ai][0][m][1];
                        if (wc < 2) {
                            const f32x4 cs = *(const f32x4*)(cos_m + pos * 32 + 16 * wc + 4 * fq), sn = *(const f32x4*)(sin_m + pos * 32 + 16 * wc + 4 * fq);
                            rope4(v0, v1, cs, sn);
                            float* o = out + (samp ? O_KROPE_S : O_KROPE_P) + (size_t)ro * 64 + 16 * wc + 4 * fq;
                            *(f32x4*)o = v0; *(f32x4*)(o + 32) = v1;
                            bf16_t* kb = kropeall + (size_t)kr * 64 + 16 * wc + 4 * fq;
                            *(u32x2*)kb = pack4(v0); *(u32x2*)(kb + 32) = pack4(v1);
                        } else if (wc == 2) {
                            *(f32x4*)(wi + (size_t)r * 32 + 4 * fq) = v0 * IDX_W_SCALE; *(f32x4*)(wi + (size_t)r * 32 + 16 + 4 * fq) = v1 * IDX_W_SCALE;
                        }
                    }
                    {
                        f32x4 v0 = acc[ai][1][m][0], v1 = acc[ai][1][m][1];
                        if (wc == 0) { const f32x4 cs = *(const f32x4*)(cos_d + pos * 16 + 4 * fq), sn = *(const f32x4*)(sin_d + pos * 16 + 4 * fq); rope4(v0, v1, cs, sn); }
                        const int c0 = wc * 32 + 4 * fq;
                        float* o = out + (samp ? O_KI_S : O_KI_P) + (size_t)ro * 128 + c0;
                        *(f32x4*)o = v0; *(f32x4*)(o + 16) = v1;
                        bf16_t* kb = kiall + (size_t)kr * 128 + c0;
                        *(u32x2*)kb = pack4(v0); *(u32x2*)(kb + 16) = pack4(v1);
                    }
                }
            }
    }
    template <bool HU> __device__ __forceinline__ void staged(const f32x4 (&acc)[2][2][4][2], const Unit& u, int wr, int wc, int fr, int fq, PG8_LAS unsigned char* stg, int lane) const {
        const int pn = u.pn;
        const int kind = pn < 22 ? 0 : pn < 26 ? 1 : pn < 30 ? 2 : pn < 46 ? 3 : pn < 62 ? 4 : 5;
        if (pn < 6 || pn >= 78 || kind == 1 || kind == 2) { this->template run<HU>(acc, u, wr, wc, fr, fq); return; }
        const int t0 = kind == 0 ? 6 : kind == 3 ? 30 : kind == 4 ? 46 : 62;
        const bool roped = (kind == 0 || kind == 3);
        bf16_t* const d0 = qb; bf16_t* const d3 = qi; bf16_t* const d4 = sga; bf16_t* const d5 = sgb;
        bf16_t* dst = kind == 0 ? d0 : kind == 3 ? d3 : kind == 4 ? d4 : d5;
        RowStage R; R.init(stg, wr, wc, lane);
        unsigned wo[4];
#pragma unroll
        for (int k = 0; k < 4; ++k) wo[k] = RowStage::woff(fr, 32 * (k >> 1) + 8 * wc + 4 * (k & 1) + fq);
        const int rb = u.pm * BM + (HU && u.hf ? HALF : 0);
        bf16_t* gp = dst + (size_t)(rb + wr * 64 + 4 * wc + (lane >> 5)) * DM + (pn - t0) * BM + (lane & 31) * 8;
#pragma unroll
        for (int ai = 0; ai < (HU ? 1 : 2); ++ai)
#pragma unroll
            for (int m = 0; m < 4; ++m) {
                const int r = rb + ai * HALF + wr * 64 + m * 16 + fr, pos = row_pos(r);
                f32x4 cs = {0.f, 0.f, 0.f, 0.f}, sn = cs;
                if (roped && wc == 0) { cs = *(const f32x4*)(cos_d + pos * 16 + 4 * fq); sn = *(const f32x4*)(sin_d + pos * 16 + 4 * fq); }
                u32x2 p[4];
#pragma unroll
                for (int bj = 0; bj < 2; ++bj) {
                    f32x4 v0 = acc[ai][bj][m][0], v1 = acc[ai][bj][m][1];
                    if (roped && wc == 0) rope4(v0, v1, cs, sn);
                    if (kind == 0) { p[2 * bj] = pack4(v0 * C_DSA); p[2 * bj + 1] = pack4(v1 * C_DSA); }
                    else if (kind == 3) { p[2 * bj] = pack4(v0); p[2 * bj + 1] = pack4(v1); }
                    else { p[2 * bj] = pack4(sigmoid4(v0)); p[2 * bj + 1] = pack4(sigmoid4(v1)); }
                }
                R.step((ai | m) == 0, wo, p, gp + (size_t)(ai * HALF + m * 16) * DM, DM);
            }
        __builtin_amdgcn_s_barrier();
    }
};

struct EpiUq {
    static constexpr bool PERM = false, AFTER_DRAIN = false, STAGED = true;
    bf16_t* qan; bf16_t* qar; const float* cos_m; const float* sin_m;
    template <bool HU> __device__ __forceinline__ void run(const f32x4 (&acc)[2][2][4][2], const Unit& u, int wr, int wc, int fr, int fq) const {
        const int pn = u.pn;
#pragma unroll
        for (int ai = 0; ai < 2; ++ai)
#pragma unroll
            for (int m = 0; m < 4; ++m) {
                const int r = u.pm * BM + ai * HALF + wr * 64 + m * 16 + fr;
                if (pn < 16) {
#pragma unroll
                    for (int bj = 0; bj < 2; ++bj)
#pragma unroll
                        for (int n = 0; n < 2; ++n) *(u32x2*)(qan + (size_t)r * 4096 + pn * BM + bj * HALF + wc * 32 + n * 16 + 4 * fq) = pack4(acc[ai][bj][m][n] * C_MLA);
                } else {
                    const int pos = row_pos(r), w = wc & 1;
                    const f32x4 cs = *(const f32x4*)(cos_m + pos * 32 + 16 * w + 4 * fq), sn = *(const f32x4*)(sin_m + pos * 32 + 16 * w + 4 * fq);
#pragma unroll
                    for (int bj = 0; bj < 2; ++bj) {
                        const int head = ((pn - 16) * 2 + bj) * 2 + (wc >> 1);
                        f32x4 v0 = acc[ai][bj][m][0], v1 = acc[ai][bj][m][1];
                        rope4(v0, v1, cs, sn);
                        bf16_t* o = qar + (size_t)r * 2048 + head * 64 + 16 * w + 4 * fq;
                        *(u32x2*)o = pack4(v0 * C_MLA); *(u32x2*)(o + 32) = pack4(v1 * C_MLA);
                    }
                }
            }
    }
    template <bool HU> __device__ __forceinline__ void staged(const f32x4 (&acc)[2][2][4][2], const Unit& u, int wr, int wc, int fr, int fq, PG8_LAS unsigned char* stg, int lane) const {
        const int pn = u.pn; const bool rp = pn >= 16; const int w = wc & 1;
        RowStage R; R.init(stg, wr, wc, lane);
        unsigned wo[4];
#pragma unroll
        for (int k = 0; k < 4; ++k) wo[k] = RowStage::woff(fr, rp ? 16 * (2 * (k >> 1) + (wc >> 1)) + 8 * (k & 1) + 4 * w + fq : 32 * (k >> 1) + 8 * wc + 4 * (k & 1) + fq);
        const size_t ldo = rp ? 2048 : 4096;
        bf16_t* const e0 = qar; bf16_t* const e1 = qan;
        bf16_t* gp = (rp ? e0 + (pn - 16) * BM : e1 + pn * BM) + (size_t)(u.pm * BM + wr * 64 + 4 * wc + (lane >> 5)) * ldo + (lane & 31) * 8;
#pragma unroll
        for (int ai = 0; ai < 2; ++ai)
#pragma unroll
            for (int m = 0; m < 4; ++m) {
                const int r = u.pm * BM + ai * HALF + wr * 64 + m * 16 + fr, pos = row_pos(r);
                f32x4 cs = {0.f, 0.f, 0.f, 0.f}, sn = cs;
                if (rp) { cs = *(const f32x4*)(cos_m + pos * 32 + 16 * w + 4 * fq); sn = *(const f32x4*)(sin_m + pos * 32 + 16 * w + 4 * fq); }
                u32x2 p[4];
#pragma unroll
                for (int bj = 0; bj < 2; ++bj) {
                    f32x4 v0 = acc[ai][bj][m][0], v1 = acc[ai][bj][m][1];
                    if (rp) rope4(v0, v1, cs, sn);
                    p[2 * bj] = pack4(v0 * C_MLA); p[2 * bj + 1] = pack4(v1 * C_MLA);
                }
                R.step((ai | m) == 0, wo, p, gp + (size_t)(ai * HALF + m * 16) * ldo, ldo);
            }
        __builtin_amdgcn_s_barrier();
    }
};

struct EpiRes {
    static constexpr bool PERM = false, AFTER_DRAIN = false, STAGED = false;
    const float* xp; const float* xs; float* y; const float* gate; float* slab;
    template <bool HU> __device__ __forceinline__ void run(const f32x4 (&acc)[2][2][4][2], const Unit& u, int wr, int wc, int fr, int fq) const {
        const int col0 = u.pn * BM + wc * 32 + 4 * fq;
        if (u.sp >= 0) {
#pragma unroll
            for (int ai = 0; ai < 2; ++ai)
#pragma unroll
                for (int m = 0; m < 4; ++m) { float* o = slab + ((size_t)u.sp * BM + ai * HALF + wr * 64 + m * 16 + fr) * DM + col0;
#pragma unroll
                    for (int bj = 0; bj < 2; ++bj)
#pragma unroll
                        for (int n = 0; n < 2; ++n) *(f32x4*)(o + bj * HALF + n * 16) = acc[ai][bj][m][n]; }
            return;
        }
#pragma unroll
        for (int ai = 0; ai < 2; ++ai)
#pragma unroll
            for (int m = 0; m < 4; ++m) {
                const int r = u.pm * BM + ai * HALF + wr * 64 + m * 16 + fr;
                const float* b = (r < SEQ ? xp + (size_t)r * DM : xs + (size_t)(r - SEQ) * DM) + col0;
                const float* g = gate + (size_t)row_vec(r) * NADA + col0;
                float* o = y + (size_t)r * DM + col0;
#pragma unroll
                for (int bj = 0; bj < 2; ++bj)
#pragma unroll
                    for (int n = 0; n < 2; ++n) { const int c = bj * HALF + n * 16; *(f32x4*)(o + c) = *(const f32x4*)(b + c) + *(const f32x4*)(g + c) * acc[ai][bj][m][n]; }
            }
    }
};
template <class Epi, class Sched, bool ALIGN_EPI = false, bool SP2 = false, bool HALFU = false>
__device__ __forceinline__ void gemm_phase(PG8_LAS unsigned char* lds, const Gemm g, const Sched& S, const Epi& E) {
    const int tid = threadIdx.x, wid = __builtin_amdgcn_readfirstlane(tid >> 6), lane = tid & 63, wr = wid >> 2, wc = wid & 3, fr = lane & 15, fq = lane >> 4;
    const int K = g.K, nt_full = K / BK;
    unsigned voffA[2], voffB[2];
#pragma unroll
    for (int i = 0; i < 2; ++i) { int R, C; stage_rc(tid * 16 + i * 8192, R, C); const int Rb = Epi::PERM ? ((R & ~31) + perm32(R & 31)) : R;
        voffA[i] = (unsigned)(R * K + C) * 2u; voffB[i] = (unsigned)(Rb * K + C) * 2u; }
    const size_t kstep = (size_t)(BK * 2);
    const size_t hstep = (size_t)HALF * K * 2;
    const size_t tstep = 2 * hstep;
    const unsigned ldsw = (unsigned)wid * 1024u;
    const int aoff = lds_byte(wr * 64 + fr, fq * 8), boff = lds_byte(wc * 32 + fr, fq * 8);
#define PG8_SA(b, h) (((b) * 2 + (h)) * HTB)
#define PG8_SB(b, h) ((4 + (b) * 2 + (h)) * HTB)
#define PG8_STAGE(bufoff, gbase, voff) do { _Pragma("unroll") for (int _i = 0; _i < 2; ++_i) \
        __builtin_amdgcn_global_load_lds((const unsigned*)((const char*)(gbase) + (voff)[_i]), (PG8_LAS unsigned*)(lds + (bufoff) + ldsw + _i * 8192), 16, 0, 0); } while (0)
#define PG8_LDA(dst, b, h) do { _Pragma("unroll") for (int m = 0; m < 4; ++m) _Pragma("unroll") for (int k = 0; k < 2; ++k) dst[m][k] = *(const PG8_LAS bf16x8*)(lds + PG8_SA(b, h) + aoff + m * 2048 + k * 1024); } while (0)
#define PG8_LDB(dst, b, h) do { _Pragma("unroll") for (int n = 0; n < 2; ++n) _Pragma("unroll") for (int k = 0; k < 2; ++k) dst[n][k] = *(const PG8_LAS bf16x8*)(lds + PG8_SB(b, h) + boff + n * 2048 + k * 1024); } while (0)
#define PG8_MMA(ai, bj, At, Bt) do { __builtin_amdgcn_s_setprio(1); _Pragma("unroll") for (int m = 0; m < 4; ++m) _Pragma("unroll") for (int n = 0; n < 2; ++n) _Pragma("unroll") for (int k = 0; k < 2; ++k) \
        acc[ai][bj][m][n] = __builtin_amdgcn_mfma_f32_16x16x32_bf16(Bt[n][k], At[m][k], acc[ai][bj][m][n], 0, 0, 0); __builtin_amdgcn_s_setprio(0); } while (0)
#define PG8_WAIT_V(n) asm volatile("s_waitcnt vmcnt(" #n ")" ::: "memory")
#define PG8_WAIT_L(n) asm volatile("s_waitcnt lgkmcnt(" #n ")" ::: "memory")
#define PG8_BAR __builtin_amdgcn_s_barrier()
#define PG8_SCHED __builtin_amdgcn_sched_barrier(0)
    Unit cur, nxt; int ui = 0;
    if (!S.next(0, cur)) return;
    f32x4 acc[2][2][4][2];
#pragma unroll
    for (int a = 0; a < 2; ++a)
#pragma unroll
        for (int b = 0; b < 2; ++b)
#pragma unroll
            for (int m = 0; m < 4; ++m)
#pragma unroll
                for (int n = 0; n < 2; ++n) acc[a][b][m][n] = (f32x4){0.f, 0.f, 0.f, 0.f};
    bf16x8 At[4][2], B0[2][2], B1[2][2];
    const char* cA = (const char*)g.A + (size_t)cur.pm * tstep + (HALFU && cur.hf ? hstep : (size_t)0) + (size_t)cur.k0 * 2; const char* cB = (const char*)g.Bt + (size_t)cur.pn * tstep + (size_t)cur.k0 * 2;
    S.a_ready(cur);
    if constexpr (SP2) {
        PG8_STAGE(PG8_SB(0, 0), cB, voffB); PG8_STAGE(PG8_SB(0, 1), cB + hstep, voffB); PG8_STAGE(PG8_SA(0, 0), cA, voffA); PG8_STAGE(PG8_SA(0, 1), cA + hstep, voffA);
        if (wr == 1) PG8_BAR;
        PG8_WAIT_V(2); PG8_BAR;
        PG8_STAGE(PG8_SB(1, 0), cB + kstep, voffB); PG8_STAGE(PG8_SA(1, 0), cA + kstep, voffA); PG8_STAGE(PG8_SB(1, 1), cB + hstep + kstep, voffB);
        PG8_WAIT_V(6); PG8_BAR;
    } else {
        PG8_STAGE(PG8_SB(0, 0), cB, voffB); PG8_STAGE(PG8_SA(0, 0), cA, voffA); PG8_STAGE(PG8_SB(0, 1), cB + hstep, voffB); PG8_STAGE(PG8_SA(0, 1), cA + hstep, voffA);
        if (wr == 1) PG8_BAR;
        PG8_WAIT_V(4); PG8_BAR;
        PG8_STAGE(PG8_SB(1, 0), cB + kstep, voffB); PG8_STAGE(PG8_SA(1, 0), cA + kstep, voffA); PG8_STAGE(PG8_SB(1, 1), cB + hstep + kstep, voffB);
        PG8_WAIT_V(6); PG8_BAR;
    }
    for (;;) {
        const bool has_next = S.next(ui + 1, nxt);
        const char* nA = has_next ? (const char*)g.A + (size_t)nxt.pm * tstep + (HALFU && nxt.hf ? hstep : (size_t)0) + (size_t)nxt.k0 * 2 : cA; const char* nB = has_next ? (const char*)g.Bt + (size_t)nxt.pn * tstep + (size_t)nxt.k0 * 2 : cB;
        const int nt = cur.nt ? cur.nt : nt_full;
        for (int t = 0; t < nt; t += 2) {
            const bool last = (t == nt - 2);
            const char* a1 = cA + (size_t)(t + 1) * kstep;
            const char* a2 = last ? nA : cA + (size_t)(t + 2) * kstep; const char* b2 = last ? nB : cB + (size_t)(t + 2) * kstep;
            const char* a3 = a2 + kstep; const char* b3 = b2 + kstep;
            if (last && has_next) S.a_ready(nxt);
            if constexpr (SP2) {
            PG8_LDB(B0, 0, 0); PG8_LDB(B1, 0, 1); PG8_SCHED; PG8_LDA(At, 0, 0); PG8_STAGE(PG8_SA(1, 1), a1 + hstep, voffA);
            PG8_WAIT_V(8); PG8_WAIT_L(0); PG8_BAR; PG8_MMA(0, 0, At, B0); PG8_MMA(0, 1, At, B1); PG8_BAR; PG8_SCHED;
            PG8_LDA(At, 0, 1); PG8_STAGE(PG8_SB(0, 0), b2, voffB); PG8_STAGE(PG8_SB(0, 1), b2 + hstep, voffB); PG8_STAGE(PG8_SA(0, 0), a2, voffA);
            PG8_WAIT_V(8); PG8_WAIT_L(0); PG8_BAR; if constexpr (!HALFU) { PG8_MMA(1, 0, At, B0); PG8_MMA(1, 1, At, B1); } PG8_BAR; PG8_SCHED;
            PG8_LDB(B0, 1, 0); PG8_LDB(B1, 1, 1); PG8_SCHED; PG8_LDA(At, 1, 0); PG8_STAGE(PG8_SA(0, 1), a2 + hstep, voffA);
            PG8_WAIT_V(8); PG8_WAIT_L(0); PG8_BAR; PG8_MMA(0, 0, At, B0); PG8_MMA(0, 1, At, B1); PG8_BAR; PG8_SCHED;
            PG8_LDA(At, 1, 1); PG8_STAGE(PG8_SB(1, 0), b3, voffB); PG8_STAGE(PG8_SB(1, 1), b3 + hstep, voffB); PG8_STAGE(PG8_SA(1, 0), a3, voffA);
            PG8_WAIT_V(8); PG8_WAIT_L(0); PG8_BAR; if constexpr (!HALFU) { PG8_MMA(1, 0, At, B0); PG8_MMA(1, 1, At, B1); } PG8_BAR; PG8_SCHED;
            } else {
            PG8_LDB(B0, 0, 0); PG8_SCHED; PG8_LDA(At, 0, 0); PG8_STAGE(PG8_SA(1, 1), a1 + hstep, voffA);
            PG8_WAIT_L(8); PG8_BAR; PG8_WAIT_L(0); PG8_MMA(0, 0, At, B0); PG8_BAR; PG8_SCHED;
            PG8_LDB(B1, 0, 1); PG8_STAGE(PG8_SB(0, 0), b2, voffB);
            PG8_BAR; PG8_WAIT_L(0); PG8_MMA(0, 1, At, B1); PG8_BAR;
            PG8_LDA(At, 0, 1); PG8_STAGE(PG8_SA(0, 0), a2, voffA);
            PG8_BAR; PG8_WAIT_L(0); PG8_MMA(1, 0, At, B0); PG8_BAR; PG8_SCHED;
            PG8_STAGE(PG8_SB(0, 1), b2 + hstep, voffB);
            PG8_WAIT_V(6); PG8_BAR; PG8_MMA(1, 1, At, B1); PG8_BAR;
            PG8_LDB(B0, 1, 0); PG8_SCHED; PG8_LDA(At, 1, 0); PG8_STAGE(PG8_SA(0, 1), a2 + hstep, voffA);
            PG8_WAIT_L(8); PG8_BAR; PG8_WAIT_L(0); PG8_MMA(0, 0, At, B0); PG8_BAR; PG8_SCHED;
            PG8_LDB(B1, 1, 1); PG8_STAGE(PG8_SB(1, 0), b3, voffB);
            PG8_BAR; PG8_WAIT_L(0); PG8_MMA(0, 1, At, B1); PG8_BAR;
            PG8_LDA(At, 1, 1); PG8_STAGE(PG8_SA(1, 0), a3, voffA);
            PG8_BAR; PG8_WAIT_L(0); PG8_MMA(1, 0, At, B0); PG8_BAR; PG8_SCHED;
            PG8_STAGE(PG8_SB(1, 1), b3 + hstep, voffB);
            PG8_WAIT_V(6); PG8_BAR; PG8_MMA(1, 1, At, B1); PG8_BAR;
            }
        }
        if constexpr (ALIGN_EPI) { if (wr == 0) PG8_BAR; }
        if constexpr (!Epi::AFTER_DRAIN) {
            if constexpr (Epi::STAGED) E.template staged<HALFU>(acc, cur, wr, wc, fr, fq, lds + PG8_SA(1, 1), lane);
            else E.template run<HALFU>(acc, cur, wr, wc, fr, fq);
            S.done(cur); }
        if (!has_next) break;
#pragma unroll
        for (int a = 0; a < 2; ++a)
#pragma unroll
            for (int b = 0; b < 2; ++b)
#pragma unroll
                for (int m = 0; m < 4; ++m)
#pragma unroll
                    for (int n = 0; n < 2; ++n) acc[a][b][m][n] = (f32x4){0.f, 0.f, 0.f, 0.f};
        cur = nxt; cA = nA; cB = nB; ++ui;
        if constexpr (ALIGN_EPI) { if (wr == 1) PG8_BAR; }
    }
    PG8_WAIT_V(0);
    if constexpr (!ALIGN_EPI) { if (wr == 0) PG8_BAR; }
    PG8_BAR;
    if constexpr (Epi::AFTER_DRAIN) { E.fused(acc, cur, wr, wc, fr, fq, lds, wid, lane); S.done(cur); }
#undef PG8_SA
#undef PG8_SB
#undef PG8_STAGE
#undef PG8_LDA
#undef PG8_LDB
#undef PG8_MMA
#undef PG8_WAIT_V
#undef PG8_WAIT_L
#undef PG8_BAR
#undef PG8_SCHED
}
}
#define XB_TMO      128
#define XB_XCNT(j)  (256  + 64 * (j))
#define XB_XSUB(j)  (1280 + 64 * (j))
#define XB_XGEN(j)  (2304 + 64 * (j))
#define XB_TOP      3328
#define XB_TOPGEN   3392
#define XCD_BAR_WORDS 3456
#define XB_SPIN_CAP (1u << 18)

__device__ __forceinline__ unsigned xb_ld(unsigned* p)              { return __hip_atomic_load(p, __ATOMIC_RELAXED, __HIP_MEMORY_SCOPE_AGENT); }
__device__ __forceinline__ unsigned xb_add(unsigned* p, unsigned v) { return __hip_atomic_fetch_add(p, v, __ATOMIC_RELAXED, __HIP_MEMORY_SCOPE_AGENT); }
__device__ __forceinline__ unsigned xb_xcc_id() { return (unsigned)__builtin_amdgcn_s_getreg((3 << 11) | 20) & 0xFu; }
#define XB_SPIN(cond, bar) do { unsigned _sp = 0; while (cond) { __builtin_amdgcn_s_sleep(1); \
    if ((++_sp & 255u) == 0u) { if (xb_ld(&(bar)[XB_TMO])) break; if (_sp > XB_SPIN_CAP) { atomicAdd(&(bar)[XB_TMO], 1u); break; } } } } while (0)

struct XcdBarrier {
    unsigned* bar; unsigned x;
    volatile LAS unsigned* st;
};

__device__ __forceinline__ XcdBarrier xcd_barrier_post(unsigned* bar, volatile LAS unsigned* st) {
    XcdBarrier b; b.bar = bar; b.x = xb_xcc_id(); b.st = st;
    if (threadIdx.x == 0) (void)xb_add(&bar[XB_XCNT(b.x)], 1u);
    return b;
}
__device__ __forceinline__ void xcd_barrier_complete(unsigned* bar, unsigned x, unsigned& nloc, unsigned& nx) {
    const unsigned G = gridDim.x * gridDim.y * gridDim.z;
    unsigned sum, cnt, mine, sp = 0u;
    for (;;) {
        sum = 0u; cnt = 0u; mine = 0u;
#pragma unroll
        for (unsigned j = 0; j < 16; ++j) { const unsigned c = xb_ld(&bar[XB_XCNT(j)]); sum += c; cnt += (c > 0u) ? 1u : 0u; mine = (j == x) ? c : mine; }
        if (sum == G) break;
        __builtin_amdgcn_s_sleep(1);
        if ((++sp & 255u) == 0u) { if (xb_ld(&bar[XB_TMO])) break; if (sp > XB_SPIN_CAP) { atomicAdd(&bar[XB_TMO], 1u); break; } }
    }
    nloc = mine > 0u ? mine : 1u; nx = cnt > 0u ? cnt : 1u;
}

__device__ __forceinline__ void xcd_barrier(const XcdBarrier& b) {
    asm volatile("s_waitcnt vmcnt(0)" ::: "memory");
    __syncthreads();
    if (threadIdx.x == 0) {
        unsigned* bar = b.bar;
        __builtin_amdgcn_s_waitcnt(0);
        unsigned nloc = b.st[0], nx = b.st[1];
        if (nloc == 0u) { xcd_barrier_complete(bar, b.x, nloc, nx); b.st[0] = nloc; b.st[1] = nx; }
        const unsigned old = xb_add(&bar[XB_XSUB(b.x)], 1u);
        const unsigned gen = old / nloc;
        if (old + 1u == (gen + 1u) * nloc) {
            __builtin_amdgcn_fence(__ATOMIC_RELEASE, "agent");
            asm volatile("s_waitcnt vmcnt(0)" ::: "memory");
            const unsigned og = xb_add(&bar[XB_TOP], 1u);
            const unsigned tg = og / nx;
            if (og + 1u == (tg + 1u) * nx) xb_add(&bar[XB_TOPGEN], 1u);
            else XB_SPIN(xb_ld(&bar[XB_TOPGEN]) == tg, bar);
            __builtin_amdgcn_fence(__ATOMIC_ACQUIRE, "agent");
            xb_add(&bar[XB_XGEN(b.x)], 1u);
            asm volatile("s_waitcnt vmcnt(0)" ::: "memory");
        } else {
            XB_SPIN(xb_ld(&bar[XB_XGEN(b.x)]) == gen, bar);
            __builtin_amdgcn_fence(__ATOMIC_ACQUIRE, "agent");
            asm volatile("s_waitcnt vmcnt(0)" ::: "memory");
        }
    }
    __syncthreads();
}

constexpr int NWAVES = 8;
struct Args { const float* in[N_IN]; float* out; unsigned char* ws; int ph_lo, ph_hi, li, pad; };
struct Ctx {
    LAS unsigned char* lds; const Args* a; unsigned char* ws; float* out;
    int tid, lane, wave, G, bx;
};
__device__ __forceinline__ float silu(float x) { return x / (1.0f + __expf(-x)); }

constexpr int ADA_NSPLIT = 21, ADA_NCG = NADA / 4 / 512;
constexpr int ADA_WCG = NADA / 4 / 64;
__device__ __forceinline__ void p0_wave_item(const Ctx& C, int item) {
    if (item >= ADA_WCG * ADA_NSPLIT) return;
    LAS float* sv = (LAS float*)(C.lds + C.wave * 16384);
    const float* cp = C.a->in[I_CP]; const float* cs = C.a->in[I_CS]; const float* W = C.a->in[I_WADA]; const float* B = C.a->in[I_BADA];
    float* ada = (float*)(C.ws + WS_ADA); const int lane = C.lane;
    const int cg = item % ADA_WCG, sp = item / ADA_WCG;
    const int d0 = sp * DM / ADA_NSPLIT, d1 = (sp + 1) * DM / ADA_NSPLIT, dn = d1 - d0;
    LDS_WAIT(); asm volatile("" ::: "memory");
    for (int i = lane; i < dn * NVEC; i += 64) { const int d = i / NVEC, v = i % NVEC; const float x = v == 0 ? cp[d0 + d] : cs[(size_t)(v - 1) * DM + d0 + d]; sv[d * 20 + v] = silu(x); }
    LDS_WAIT(); asm volatile("" ::: "memory");
    const int e0 = (cg * 64 + lane) * 4;
    v4f acc[NVEC];
#pragma unroll
    for (int v = 0; v < NVEC; ++v) acc[v] = (v4f){0.f, 0.f, 0.f, 0.f};
    const float* wp = W + (size_t)d0 * NADA + e0;
    int d = 0;
    for (; d + 4 <= dn; d += 4) {
        v4f w[4];
#pragma unroll
        for (int k = 0; k < 4; ++k) w[k] = __builtin_nontemporal_load((const v4f*)(wp + (size_t)(d + k) * NADA));
#pragma unroll
        for (int k = 0; k < 4; ++k) {
            const LAS v4f* s4 = (const LAS v4f*)(sv + (d + k) * 20);
            const v4f s0 = s4[0], s1 = s4[1], s2 = s4[2], s3 = s4[3]; const float s16 = sv[(d + k) * 20 + 16];
#pragma unroll
            for (int v = 0; v < 4; ++v) { acc[v] += s0[v] * w[k]; acc[4 + v] += s1[v] * w[k]; acc[8 + v] += s2[v] * w[k]; acc[12 + v] += s3[v] * w[k]; }
            acc[16] += s16 * w[k];
        }
    }
    for (; d < dn; ++d) { const v4f w = *(const v4f*)(wp + (size_t)d * NADA);
#pragma unroll
        for (int v = 0; v < NVEC; ++v) acc[v] += sv[d * 20 + v] * w; }
    if (sp == 0) { const v4f b = *(const v4f*)(B + e0);
#pragma unroll
        for (int v = 0; v < NVEC; ++v) acc[v] += b; }
#pragma unroll
    for (int v = 0; v < NVEC; ++v)
#pragma unroll
        for (int e = 0; e < 4; ++e) atomicAdd(ada + (size_t)v * NADA + e0 + e, acc[v][e]);
    LDS_WAIT(); asm volatile("" ::: "memory");
}

__device__ __forceinline__ int kperm64(int d) { return 32 * ((d >> 4) & 1) + 16 * (d >> 5) + (d & 15); }
__device__ __forceinline__ int win_dst(int n) {
    if (n < 1536) return n;
    if (n < 1600) return 78 * 256 + kperm64(n - 1536);
    if (n < 5696) return 6 * 256 + (n - 1600);
    if (n < 6720) return 22 * 256 + (n - 5696);
    if (n < 7744) return 26 * 256 + (n - 6720);
    if (n < 11840) return 30 * 256 + (n - 7744);
    if (n < 11968) return 78 * 256 + 128 + (n - 11840);
    if (n < 12000) return 78 * 256 + 64 + (n - 11968);
    if (n < 16096) return 46 * 256 + (n - 12000);
    return 62 * 256 + (n - 16096);
}
__device__ __forceinline__ int wuq_dst(int n) { const int h = n / 192, dd = n % 192; return dd < 128 ? h * 128 + dd : 4096 + (h >> 1) * 128 + (h & 1) * 64 + kperm64(dd - 128); }
template <int MAP> __device__ __forceinline__ void transpose_item(const float* W, int K, int N, bf16* WT, int row_off, LAS float* scr, int item, int lane) {
    const int nblk = N / 32, kb = item / nblk, nb = item % nblk, k0 = 64 * kb, n0 = 32 * nb;
#pragma unroll 8
    for (int i = 0; i < 32; ++i) { const int kk = 2 * i + (lane >> 5); scr[kk * 33 + (lane & 31)] = __builtin_nontemporal_load(W + (size_t)(k0 + kk) * N + n0 + (lane & 31)); }
    LDS_WAIT(); asm volatile("" ::: "memory");
    const int c = lane & 7;
#pragma unroll
    for (int j = 0; j < 4; ++j) { const int n = (lane >> 3) + 8 * j; const LAS float* s = scr + (8 * c) * 33 + n;
        v4u o; o.x = pk2(s[0 * 33], s[1 * 33]); o.y = pk2(s[2 * 33], s[3 * 33]); o.z = pk2(s[4 * 33], s[5 * 33]); o.w = pk2(s[6 * 33], s[7 * 33]);
        const int dr = MAP == 1 ? win_dst(n0 + n) : MAP == 2 ? wuq_dst(n0 + n) : n0 + n;
        *(GAS v4u*)(WT + (size_t)(row_off + dr) * K + k0 + 8 * c) = o; }
    LDS_WAIT(); asm volatile("" ::: "memory");
}
__device__ __forceinline__ void cvt_row(const float* src, bf16* dst, int n, int lane) {
    for (int i = lane * 8; i < n; i += 512) { const v4f a = *(const v4f*)(src + i), b = *(const v4f*)(src + i + 4);
        v4u o; o.x = pk2(a[0], a[1]); o.y = pk2(a[2], a[3]); o.z = pk2(b[0], b[1]); o.w = pk2(b[2], b[3]); *(v4u*)(dst + i) = o; }
}
__device__ __forceinline__ void zero_row(bf16* dst, int n, int lane) { for (int i = lane * 8; i < n; i += 512) *(v4u*)(dst + i) = (v4u){0u, 0u, 0u, 0u}; }
__device__ __forceinline__ void sincos_acc(float a, float& c, float& s) {
    const double x = (double)a; const double q = __builtin_rint(x * 0.63661977236758134308);
    const double t = (x - q * 1.5707963267948965580) - q * 6.1232339957367658860e-17, t2 = t * t;
    double sp = 1.0 / 6227020800.0; sp = sp * t2 - 1.0 / 39916800.0; sp = sp * t2 + 1.0 / 362880.0; sp = sp * t2 - 1.0 / 5040.0; sp = sp * t2 + 1.0 / 120.0; sp = sp * t2 - 1.0 / 6.0; sp = sp * t2 + 1.0;
    const double sn = sp * t;
    double cp = -1.0 / 87178291200.0; cp = cp * t2 + 1.0 / 479001600.0; cp = cp * t2 - 1.0 / 3628800.0; cp = cp * t2 + 1.0 / 40320.0; cp = cp * t2 - 1.0 / 720.0; cp = cp * t2 + 1.0 / 24.0; cp = cp * t2 - 0.5; cp = cp * t2 + 1.0;
    const int k = (int)((long long)q & 3);
    const double cc = (k == 0) ? cp : (k == 1) ? -sn : (k == 2) ? -cp : sn;
    const double ss = (k == 0) ? sn : (k == 1) ? cp : (k == 2) ? -sn : -cp;
    c = (float)cc; s = (float)ss;
}
__device__ __forceinline__ float pow_int(double base, int j) { double r = 1.0; for (int i = 0; i < j; ++i) r *= base; return (float)r; }
__device__ __forceinline__ void modnorm_row(const float* xrow, const float* g, const float* sc, const float* sh, bf16* orow, int lane) {
    v4f v[16]; float s = 0.f;
#pragma unroll
    for (int j = 0; j < 16; ++j) { v[j] = *(const v4f*)(xrow + 4 * lane + 256 * j); s += (v[j][0] * v[j][0] + v[j][1] * v[j][1]) + (v[j][2] * v[j][2] + v[j][3] * v[j][3]); }
    const float rstd = 1.0f / sqrtf(wave_sum(s) * (1.0f / DM) + EPS);
#pragma unroll
    for (int j = 0; j < 16; ++j) { const int c = 4 * lane + 256 * j; const v4f gg = *(const v4f*)(g + c), a = *(const v4f*)(sc + c), b = *(const v4f*)(sh + c);
        const v4f y = (v[j] * rstd) * gg * (a + 1.0f) + b; v2u o; o.x = pk2(y[0], y[1]); o.y = pk2(y[2], y[3]); *(v2u*)(orow + c) = o; }
}
__device__ __forceinline__ void p01_gemv_and_copies(const Ctx& C) {
    if (C.wave < 4) for (int it = C.bx * 4 + C.wave; it < ADA_WCG * ADA_NSPLIT; it += 8 * C.G) p0_wave_item(C, it);
    LAS float* scr = (LAS float*)(C.lds + C.wave * 16384);
    const int gw = C.bx * NWAVES + C.wave, NGW = C.G * NWAVES, lane = C.lane;
    const Args& A = *C.a; unsigned char* ws = C.ws;
    constexpr int I_IN = (DM / 64) * (DIN / 32), I_UQ = (QLORA / 64) * (6144 / 32), I_UK = (KVLORA / 64) * (4096 / 32), I_OUT = (DM / 64) * (DM / 32), I_UP = (DM / 64) * (DFF / 32), I_DN = (DFF / 64) * (DM / 32);
    constexpr int NITEMS = I_IN + I_UQ + 2 * I_UK + I_OUT + I_UP + I_DN;
    for (int it = gw; it < NITEMS; it += NGW) {
        int r = it;
        if (r < I_IN) { transpose_item<1>(A.in[I_WIN], DM, DIN, (bf16*)(ws + WS_WIN), 0, scr, r, lane); continue; } r -= I_IN;
        if (r < I_UQ) { transpose_item<2>(A.in[I_WUQ], QLORA, 6144, (bf16*)(ws + WS_WUQ), 0, scr, r, lane); continue; } r -= I_UQ;
        if (r < I_UK) { transpose_item<0>(A.in[I_WUK], KVLORA, 4096, (bf16*)(ws + WS_WUKV), 0, scr, r, lane); continue; } r -= I_UK;
        if (r < I_UK) { transpose_item<0>(A.in[I_WUV], KVLORA, 4096, (bf16*)(ws + WS_WUKV), 4096, scr, r, lane); continue; } r -= I_UK;
        if (r < I_OUT) { transpose_item<0>(A.in[I_WOUT], DM, DM, (bf16*)(ws + WS_WOUT), 0, scr, r, lane); continue; } r -= I_OUT;
        if (r < I_UP) { transpose_item<0>(A.in[I_WUP], DM, DFF, (bf16*)(ws + WS_WUP), 0, scr, r, lane); continue; } r -= I_UP;
        transpose_item<0>(A.in[I_WDOWN], DFF, DM, (bf16*)(ws + WS_WDOWN), 0, scr, r, lane);
    }
    for (int i = gw; i < 32; i += NGW) zero_row((bf16*)(ws + WS_WIN) + (size_t)(78 * 256 + 96 + i) * DM, DM, lane);
    for (int i = gw; i < DEC_B * SPITCH; i += NGW) {
        const int b = i / SPITCH, l = i % SPITCH; const size_t kr = (size_t)SEQ + i, cr = (size_t)b * PAST + l;
        bf16* ck = (bf16*)(ws + WS_CKV) + kr * 512; bf16* kp = (bf16*)(ws + WS_KROPE) + kr * 64; bf16* ka = (bf16*)(ws + WS_KALL) + kr * 1024; bf16* va = (bf16*)(ws + WS_VALL) + kr * 1024; bf16* ki = (bf16*)(ws + WS_KI) + kr * 128;
        if (l < PAST) { cvt_row(A.in[I_CCKV] + cr * 512, ck, 512, lane); cvt_row(A.in[I_CKROPE] + cr * 64, kp, 64, lane); cvt_row(A.in[I_CK] + cr * 1024, ka, 1024, lane);
                        cvt_row(A.in[I_CV] + cr * 1024, va, 1024, lane); cvt_row(A.in[I_CKI] + cr * 128, ki, 128, lane); }
        else if (l >= SKEYS) { zero_row(ck, 512, lane); zero_row(kp, 64, lane); zero_row(ka, 1024, lane); zero_row(va, 1024, lane); zero_row(ki, 128, lane); }
    }
    {
        float* cm = (float*)(ws + WS_ROPE); float* sm = cm + SEQ * 32; float* cd = sm + SEQ * 32; float* sd = cd + SEQ * 16;
        for (int i = gw * 64 + lane; i < SEQ * 48; i += NGW * 64) {
            const int pos = i / 48, j = i % 48; float c, s;
            if (j < 32) { const float inv = pow_int(0.74989420933245582730, j); sincos_acc((float)pos * inv, c, s); cm[pos * 32 + j] = c; sm[pos * 32 + j] = s; }
            else { const int k = j - 32; const float inv = pow_int(0.44036660267178047359, k); sincos_acc((float)pos * inv, c, s); cd[pos * 16 + k] = c; sd[pos * 16 + k] = s; }
        }
    }
    if (C.wave >= 4) for (int it = (C.G + C.bx) * 4 + (C.wave - 4); it < ADA_WCG * ADA_NSPLIT; it += 8 * C.G) p0_wave_item(C, it);
}
__device__ __forceinline__ void p1_modnorm(const Ctx& C) {
    const int gw = C.bx * NWAVES + C.wave, NGW = C.G * NWAVES, lane = C.lane;
    const Args& A = *C.a; unsigned char* ws = C.ws;
    {
        const float* ada = (const float*)(ws + WS_ADA);
        for (int r = gw; r < NROW; r += NGW) {
            const float* xr = r < SEQ ? A.in[I_XP] + (size_t)r * DM : A.in[I_XS] + (size_t)(r - SEQ) * DM; const float* av = ada + (size_t)row_vec(r) * NADA;
            modnorm_row(xr, A.in[I_G1], av + 1 * DM, av + 0 * DM, (bf16*)(ws + WS_XN) + (size_t)r * DM, lane);
        }
    }
}
__device__ __forceinline__ void p3_norms(const Ctx& C) {
    const int gw = C.bx * NWAVES + C.wave, NGW = C.G * NWAVES, lane = C.lane; const Args& A = *C.a; unsigned char* ws = C.ws;
    const float* gq = A.in[I_GQ]; const float* gkv = A.in[I_GKV];
    for (int r = gw; r < NROW; r += NGW) {
        {
            const float* x = (const float*)(ws + WS_QRAW) + (size_t)r * QLORA; v4f v[4]; float s = 0.f;
#pragma unroll
            for (int j = 0; j < 4; ++j) { v[j] = *(const v4f*)(x + 4 * lane + 256 * j); s += (v[j][0] * v[j][0] + v[j][1] * v[j][1]) + (v[j][2] * v[j][2] + v[j][3] * v[j][3]); }
            const float rstd = 1.0f / sqrtf(wave_sum(s) * (1.0f / QLORA) + EPS); bf16* o = (bf16*)(ws + WS_QN) + (size_t)r * QLORA;
#pragma unroll
            for (int j = 0; j < 4; ++j) { const int c = 4 * lane + 256 * j; const v4f y = (v[j] * rstd) * *(const v4f*)(gq + c); v2u w; w.x = pk2(y[0], y[1]); w.y = pk2(y[2], y[3]); *(v2u*)(o + c) = w; }
        }
        {
            const float* x = (const float*)(ws + WS_CKVRAW) + (size_t)r * KVLORA; v4f v[2]; float s = 0.f;
#pragma unroll
            for (int j = 0; j < 2; ++j) { v[j] = *(const v4f*)(x + 4 * lane + 256 * j); s += (v[j][0] * v[j][0] + v[j][1] * v[j][1]) + (v[j][2] * v[j][2] + v[j][3] * v[j][3]); }
            const float rstd = 1.0f / sqrtf(wave_sum(s) * (1.0f / KVLORA) + EPS);
            float* of = C.out + (r < SEQ ? O_CKV_P + (size_t)r * KVLORA : O_CKV_S + (size_t)(r - SEQ) * KVLORA); bf16* ob = (bf16*)(ws + WS_CKV) + (size_t)row_key(r) * KVLORA;
#pragma unroll
            for (int j = 0; j < 2; ++j) { const int c = 4 * lane + 256 * j; const v4f y = (v[j] * rstd) * *(const v4f*)(gkv + c); *(v4f*)(of + c) = y; v2u w; w.x = pk2(y[0], y[1]); w.y = pk2(y[2], y[3]); *(v2u*)(ob + c) = w; }
        }
    }
}
template <int S> __device__ __forceinline__ void sample_row_sum(const Ctx& C, int i, const float* base, const float* gate, v4f (&v)[2], float& rstd) {
    const float* slab = (const float*)(C.ws + WS_SLAB); LAS float* red = (LAS float*)C.lds; float ss = 0.f;
#pragma unroll
    for (int j = 0; j < 2; ++j) { const int c = 512 * C.wave + 4 * C.lane + 256 * j; v4f a = {0.f, 0.f, 0.f, 0.f};
#pragma unroll
        for (int s = 0; s < S; ++s) a += *(const v4f*)(slab + ((size_t)s * 256 + i) * DM + c);
        v[j] = *(const v4f*)(base + c) + *(const v4f*)(gate + c) * a; ss += (v[j][0] * v[j][0] + v[j][1] * v[j][1]) + (v[j][2] * v[j][2] + v[j][3] * v[j][3]); }
    ss = wave_sum(ss); __syncthreads(); if (C.lane == 0) red[C.wave] = ss; __syncthreads();
    float t = 0.f;
#pragma unroll
    for (int w = 0; w < 8; ++w) t += red[w];
    rstd = 1.0f / sqrtf(t * (1.0f / DM) + EPS);
}
__device__ __forceinline__ void p9_h2(const Ctx& C) {
    const int gw = C.bx * NWAVES + C.wave, NGW = C.G * NWAVES; const Args& A = *C.a; const float* ada = (const float*)(C.ws + WS_ADA);
    for (int i = C.bx; i < NSAMP; i += C.G) {
        const int r = SEQ + i; const float* av = ada + (size_t)row_vec(r) * NADA; v4f v[2]; float rstd;
        sample_row_sum<SPLIT_OUT>(C, i, A.in[I_XS] + (size_t)i * DM, av + 2 * DM, v, rstd);
#pragma unroll
        for (int j = 0; j < 2; ++j) { const int c = 512 * C.wave + 4 * C.lane + 256 * j; *(v4f*)(C.out + O_Y + (size_t)r * DM + c) = v[j];
            const v4f y = (v[j] * rstd) * *(const v4f*)(A.in[I_G2] + c) * (*(const v4f*)(av + 4 * DM + c) + 1.0f) + *(const v4f*)(av + 3 * DM + c);
            v2u o; o.x = pk2(y[0], y[1]); o.y = pk2(y[2], y[3]); *(v2u*)((bf16*)(C.ws + WS_XN) + (size_t)r * DM + c) = o; }
    }
    for (int r = gw; r < SEQ; r += NGW) { const float* av = ada + (size_t)row_vec(r) * NADA;
        modnorm_row(C.out + O_Y + (size_t)r * DM, A.in[I_G2], av + 4 * DM, av + 3 * DM, (bf16*)(C.ws + WS_XN) + (size_t)r * DM, C.lane); }
}
__device__ __forceinline__ void p12_final(const Ctx& C) {
    const int gw = C.bx * NWAVES + C.wave, NGW = C.G * NWAVES, lane = C.lane; const float* g = C.a->in[I_GF]; const float* ada = (const float*)(C.ws + WS_ADA);
    for (int i = C.bx; i < NSAMP; i += C.G) {
        const int r = SEQ + i; const float* av = ada + (size_t)row_vec(r) * NADA; v4f v[2]; float rstd; float* y = C.out + O_Y + (size_t)r * DM;
        sample_row_sum<SPLIT_DOWN>(C, i, y, av + 5 * DM, v, rstd);
#pragma unroll
        for (int j = 0; j < 2; ++j) { const int c = 512 * C.wave + 4 * C.lane + 256 * j; *(v4f*)(y + c) = (v[j] * rstd) * *(const v4f*)(g + c); }
    }
    for (int r = gw; r < SEQ; r += NGW) {
        float* x = C.out + O_Y + (size_t)r * DM; v4f v[16]; float s = 0.f;
#pragma unroll
        for (int j = 0; j < 16; ++j) { v[j] = *(const v4f*)(x + 4 * lane + 256 * j); s += (v[j][0] * v[j][0] + v[j][1] * v[j][1]) + (v[j][2] * v[j][2] + v[j][3] * v[j][3]); }
        const float rstd = 1.0f / sqrtf(wave_sum(s) * (1.0f / DM) + EPS);
#pragma unroll
        for (int j = 0; j < 16; ++j) { const int c = 4 * lane + 256 * j; *(v4f*)(x + c) = (v[j] * rstd) * *(const v4f*)(g + c); }
    }
}
namespace att {
typedef short bf16x8 __attribute__((ext_vector_type(8)));
typedef short s16x4 __attribute__((ext_vector_type(4)));
typedef float f32x16 __attribute__((ext_vector_type(16)));
typedef unsigned u32x4 __attribute__((ext_vector_type(4)));
typedef unsigned long long u64;
constexpr int L_KN = 0, L_V = 32768, L_KR = 81920, L_WS = 98304, L_END = 100352;
#define SBAR() __builtin_amdgcn_sched_barrier(0)
#define BAR() do { __builtin_amdgcn_s_barrier(); asm volatile("" ::: "memory"); } while (0)
__device__ __forceinline__ int crow(int r, int hi) { return (r & 3) + 8 * (r >> 2) + 4 * hi; }
__device__ __forceinline__ unsigned cvtpk(float lo, float hi) { return pg8::cvt_pk_bf16(lo, hi); }
__device__ __forceinline__ int swap23(int k) { return (k & ~0xC) | ((k & 4) << 1) | ((k & 8) >> 1); }
__device__ __forceinline__ void glds(const void* g, LAS unsigned char* l) { __builtin_amdgcn_global_load_lds((const unsigned*)g, (LAS unsigned*)l, 16, 0, 0); }
template <int OFF> __device__ __forceinline__ s16x4 tr_read(unsigned vb) { s16x4 r; asm volatile("ds_read_b64_tr_b16 %0, %1 offset:%2" : "=&v"(r) : "v"(vb), "i"(OFF) : "memory"); return r; }
constexpr int v_rd_off(int d0, int ks, int half) { return d0 * 512 + ks * 4096 + half * 2048; }
__device__ __forceinline__ unsigned v_rd_base(int lane) { return ((lane & 3) << 3) | (((lane >> 2) & 3) << 6) | (((lane >> 4) & 1) << 5) | (((lane >> 5) & 1) << 8); }
struct VFrag { s16x4 l0, h0, l1, h1, l2, h2, l3, h3; };
template <int D0> __device__ __forceinline__ void pv_read(VFrag& f, unsigned vb) {
    f.l0 = tr_read<v_rd_off(D0, 0, 0)>(vb); f.h0 = tr_read<v_rd_off(D0, 0, 1)>(vb); f.l1 = tr_read<v_rd_off(D0, 1, 0)>(vb); f.h1 = tr_read<v_rd_off(D0, 1, 1)>(vb);
    f.l2 = tr_read<v_rd_off(D0, 2, 0)>(vb); f.h2 = tr_read<v_rd_off(D0, 2, 1)>(vb); f.l3 = tr_read<v_rd_off(D0, 3, 0)>(vb); f.h3 = tr_read<v_rd_off(D0, 3, 1)>(vb);
}
__device__ __forceinline__ void pv_mma(f32x16& od, const VFrag& f, bf16x8 pa0, bf16x8 pa1, bf16x8 pa2, bf16x8 pa3) {
#define PK(L, H) (bf16x8){L[0], L[1], L[2], L[3], H[0], H[1], H[2], H[3]}
    od = __builtin_amdgcn_mfma_f32_32x32x16_bf16(pa0, PK(f.l0, f.h0), od, 0, 0, 0);
    od = __builtin_amdgcn_mfma_f32_32x32x16_bf16(pa1, PK(f.l1, f.h1), od, 0, 0, 0);
    od = __builtin_amdgcn_mfma_f32_32x32x16_bf16(pa2, PK(f.l2, f.h2), od, 0, 0, 0);
    od = __builtin_amdgcn_mfma_f32_32x32x16_bf16(pa3, PK(f.l3, f.h3), od, 0, 0, 0);
#undef PK
}
__device__ __forceinline__ void pv_all(f32x16 (&o)[4], unsigned vb, bf16x8 pa0, bf16x8 pa1, bf16x8 pa2, bf16x8 pa3) {
    VFrag fa, fb;
    pv_read<0>(fa, vb);
    pv_read<1>(fb, vb); asm volatile("s_waitcnt lgkmcnt(8)" ::: "memory"); SBAR(); pv_mma(o[0], fa, pa0, pa1, pa2, pa3); SBAR();
    pv_read<2>(fa, vb); asm volatile("s_waitcnt lgkmcnt(8)" ::: "memory"); SBAR(); pv_mma(o[1], fb, pa0, pa1, pa2, pa3); SBAR();
    pv_read<3>(fb, vb); asm volatile("s_waitcnt lgkmcnt(8)" ::: "memory"); SBAR(); pv_mma(o[2], fa, pa0, pa1, pa2, pa3); SBAR();
    asm volatile("s_waitcnt lgkmcnt(0)" ::: "memory"); SBAR(); pv_mma(o[3], fb, pa0, pa1, pa2, pa3);
}

struct Desc {
    const bf16* K; int ldk; const bf16* Kr; const bf16* V; int ldv; int NT, nvis;
    u64 lastmask;
    int tok0, tmask, hshift, hcol0, nvalid;
};
template <int KIND>
__device__ __forceinline__ void attn_unit(LAS unsigned char* lds, const Desc& D, const bf16* QN, const bf16* QR, const u64* MASK, const bf16* GATE, const bf16* ADDB, bf16* OUT, int wid, int lane) {
    constexpr int NQ = KIND == 0 ? 12 : 8;
    asm volatile("" : "+v"(lane));
    const int r32 = lane & 31, hi = lane >> 5;
    LAS float* wsf = (LAS float*)(lds + L_WS) + wid * 64;
    asm volatile("s_waitcnt vmcnt(0) lgkmcnt(0)" ::: "memory"); BAR();
    const bool active = D.nvis > 0;
    const int qtok = D.tok0 + (r32 & D.tmask), qcol = D.hcol0 + (r32 >> D.hshift) * 128;
    bf16x8 qr[NQ];
    {
        const bf16* qp = QN + (size_t)qtok * 4096 + qcol + hi * 8;
#pragma unroll
        for (int d0 = 0; d0 < 8; ++d0) qr[d0] = *(const bf16x8*)(qp + d0 * 16);
        if constexpr (KIND == 0) { const bf16* qp2 = QR + (size_t)qtok * 2048 + (qcol >> 1) + hi * 8;
#pragma unroll
            for (int d0 = 0; d0 < 4; ++d0) qr[8 + d0] = *(const bf16x8*)(qp2 + d0 * 16); }
    }
    const u64* mrow = MASK + (size_t)qtok * 128;
    int kn_off[2], v_off[2], kr_off = 0;
#pragma unroll
    for (int i = 0; i < 2; ++i) {
        const int row = 8 * wid + 4 * i + (lane >> 4), chunk = (lane & 15) ^ (row & 15); kn_off[i] = row * D.ldk + chunk * 8;
        const int kk = 8 * wid + ((lane & 31) >> 2), k = swap23(kk), c = 32 * (2 * i + (lane >> 5)) + (lane & 3) * 8; v_off[i] = k * D.ldv + c;
    }
    if constexpr (KIND == 0) { const int row = 8 * wid + (lane >> 3), chunk = (lane & 7) ^ ((row >> 1) & 7); kr_off = row * 64 + chunk * 8; }
#define STAGE(j, b, bv) do { const bf16* kb_ = D.K + (size_t)(j) * 64 * D.ldk; const bf16* vb_ = D.V + (size_t)(j) * 64 * D.ldv; \
        glds(kb_ + kn_off[0], lds + L_KN + (b) * 16384 + (2 * wid) * 1024); glds(kb_ + kn_off[1], lds + L_KN + (b) * 16384 + (2 * wid + 1) * 1024); \
        glds(vb_ + v_off[0], lds + L_V + (bv) * 16384 + (2 * wid) * 1024); glds(vb_ + v_off[1], lds + L_V + (bv) * 16384 + (2 * wid + 1) * 1024); \
        if constexpr (KIND == 0) glds(D.Kr + (size_t)(j) * 64 * 64 + kr_off, lds + L_KR + (b) * 8192 + wid * 1024); } while (0)
    const unsigned kq = (unsigned)(r32 * 256), kt = (unsigned)((hi ^ (r32 & 15)) << 4);
    const unsigned krq = (unsigned)(r32 * 128), krt = (unsigned)((hi ^ ((r32 >> 1) & 7)) << 4);
    const unsigned vb0 = (unsigned)(uintptr_t)(lds + L_V) + v_rd_base(lane);
    float lf = 0.f; f32x16 of[4];
    bool redo;
    {
        float l_reg = 0.f; f32x16 o[4];
    #pragma unroll
        for (int d = 0; d < 4; ++d)
    #pragma unroll
            for (int r = 0; r < 16; ++r) o[d][r] = 0.f;
        u64 mw_next = ~0ull;
        if constexpr (KIND == 1) mw_next = mrow[0];
        STAGE(0, 0, 0);
        const int half = wid >> 2; int vs = 0;
        bf16x8 pa0, pa1, pa2, pa3; { const bf16x8 z8 = {0, 0, 0, 0, 0, 0, 0, 0}; pa0 = z8; pa1 = z8; pa2 = z8; pa3 = z8; }
        for (int j = 0; j <= D.NT; ++j) {
            asm volatile("s_waitcnt vmcnt(0)" ::: "memory"); BAR();
            u64 mw = mw_next;
            const int vs1 = vs == 2 ? 0 : vs + 1, vsm = vs == 0 ? 2 : vs - 1;
            if (j + 1 < D.NT) { STAGE(j + 1, (j + 1) & 1, vs1); if constexpr (KIND == 1) mw_next = mrow[j + 1]; }
            if constexpr (KIND == 0) mw = (j == D.NT - 1) ? D.lastmask : ~0ull;
            if (half == 1 && j >= 1 && j - 1 < D.nvis) pv_all(o, vb0 + (unsigned)(vsm * 16384), pa0, pa1, pa2, pa3);
            if (j < D.NT && j < D.nvis) {
                const int b = j & 1;
                f32x16 p0, p1;
                {
                    LAS const unsigned char* kb = lds + L_KN + b * 16384 + kq;
                    constexpr int NSTEP = KIND == 0 ? 12 : 8;
                    bf16x8 ka0, ka1, kb0, kb1;
    #define KLOAD(d0_, X0, X1) do { if ((d0_) < 8) { const unsigned off_ = kt ^ (unsigned)((d0_) << 5); X0 = *(LAS const bf16x8*)(kb + off_); X1 = *(LAS const bf16x8*)(kb + 8192 + off_); } \
            else { LAS const unsigned char* kr_ = lds + L_KR + b * 8192 + krq; const unsigned off_ = krt ^ (unsigned)(((d0_) - 8) << 5); X0 = *(LAS const bf16x8*)(kr_ + off_); X1 = *(LAS const bf16x8*)(kr_ + 4096 + off_); } } while (0)
                    KLOAD(0, ka0, ka1);
    #pragma unroll
                    for (int d0 = 0; d0 < NSTEP; d0 += 2) {
                        KLOAD(d0 + 1, kb0, kb1);
                        if (d0 == 0) { const f32x16 z_ = {0.f, 0.f, 0.f, 0.f, 0.f, 0.f, 0.f, 0.f, 0.f, 0.f, 0.f, 0.f, 0.f, 0.f, 0.f, 0.f}; p0 = __builtin_amdgcn_mfma_f32_32x32x16_bf16(ka0, qr[0], z_, 0, 0, 0); p1 = __builtin_amdgcn_mfma_f32_32x32x16_bf16(ka1, qr[0], z_, 0, 0, 0); }
                        else { p0 = __builtin_amdgcn_mfma_f32_32x32x16_bf16(ka0, qr[d0], p0, 0, 0, 0); p1 = __builtin_amdgcn_mfma_f32_32x32x16_bf16(ka1, qr[d0], p1, 0, 0, 0); }
                        SBAR();
                        if (d0 + 2 < NSTEP) KLOAD(d0 + 2, ka0, ka1);
                        p0 = __builtin_amdgcn_mfma_f32_32x32x16_bf16(kb0, qr[d0 + 1], p0, 0, 0, 0); p1 = __builtin_amdgcn_mfma_f32_32x32x16_bf16(kb1, qr[d0 + 1], p1, 0, 0, 0); SBAR();
                    }
    #undef KLOAD
                }
                float ps = 0.f;
    #pragma unroll
                for (int r = 0; r < 16; ++r) { p0[r] = __builtin_amdgcn_exp2f(p0[r]); p1[r] = __builtin_amdgcn_exp2f(p1[r]); }
                if (KIND == 1 || mw != ~0ull) {
                    const unsigned lo = (unsigned)mw >> (4 * hi), hh = (unsigned)(mw >> 32) >> (4 * hi);
    #pragma unroll
                    for (int r = 0; r < 16; ++r) { const int bit = (r & 3) + 8 * (r >> 2);
                        p0[r] = __uint_as_float(__float_as_uint(p0[r]) & (unsigned)__builtin_amdgcn_sbfe((int)lo, bit, 1));
                        p1[r] = __uint_as_float(__float_as_uint(p1[r]) & (unsigned)__builtin_amdgcn_sbfe((int)hh, bit, 1)); }
                }
    #pragma unroll
                for (int r = 0; r < 16; ++r) ps += p0[r] + p1[r];
                { auto rr = __builtin_amdgcn_permlane32_swap(__float_as_uint(ps), __float_as_uint(ps), false, false); ps = __uint_as_float(rr[0]) + __uint_as_float(rr[1]); }
                l_reg += ps;
    #define PK4(P, BASE, OUT) do { unsigned a0 = cvtpk(P[BASE + 0], P[BASE + 1]), a1 = cvtpk(P[BASE + 2], P[BASE + 3]); \
        unsigned b0 = cvtpk(P[BASE + 4], P[BASE + 5]), b1 = cvtpk(P[BASE + 6], P[BASE + 7]); \
        auto r0 = __builtin_amdgcn_permlane32_swap(a0, b0, false, false); auto r1 = __builtin_amdgcn_permlane32_swap(a1, b1, false, false); \
        u32x4 w = {r0[0], r1[0], r0[1], r1[1]}; OUT = __builtin_bit_cast(bf16x8, w); } while (0)
                PK4(p0, 0, pa0); PK4(p0, 8, pa1); PK4(p1, 0, pa2); PK4(p1, 8, pa3);
    #undef PK4
                if (half == 0) pv_all(o, vb0 + (unsigned)(vs * 16384), pa0, pa1, pa2, pa3);
            }
            vs = vs1;
        }
        bool ok = l_reg > 1e-30f && l_reg < 1e30f;
#pragma unroll
        for (int d = 0; d < 4; ++d)
#pragma unroll
            for (int r = 0; r < 16; ++r) ok = ok && (fabsf(o[d][r]) < 1e30f);
        const bool bad = active && !__all(ok);
        if (!bad) { lf = l_reg;
#pragma unroll
            for (int d = 0; d < 4; ++d) of[d] = o[d]; }
        LAS unsigned* flags = (LAS unsigned*)(lds + L_END);
        if (lane == 0) flags[wid] = bad ? 1u : 0u;
        asm volatile("s_waitcnt vmcnt(0) lgkmcnt(0)" ::: "memory"); BAR();
        unsigned any = 0;
#pragma unroll
        for (int w = 0; w < 8; ++w) any |= flags[w];
        redo = any != 0u;
    }
    if (__builtin_expect(redo, 0)) {
        asm volatile("s_waitcnt vmcnt(0) lgkmcnt(0)" ::: "memory"); BAR();
        float l_reg = 0.f; f32x16 o[4];
        f32x16 negm;
    #pragma unroll
        for (int r = 0; r < 16; ++r) negm[r] = 0.f;
    #pragma unroll
        for (int d = 0; d < 4; ++d)
    #pragma unroll
            for (int r = 0; r < 16; ++r) o[d][r] = 0.f;
        u64 mw_next = ~0ull;
        if constexpr (KIND == 1) mw_next = mrow[0];
        STAGE(0, 0, 0);
        for (int j = 0; j < D.NT; ++j) {
            asm volatile("s_waitcnt vmcnt(0)" ::: "memory"); BAR();
            u64 mw = mw_next;
            if (j + 1 < D.NT) { STAGE(j + 1, (j + 1) & 1, (j + 1) % 3); if constexpr (KIND == 1) mw_next = mrow[j + 1]; }
            if constexpr (KIND == 0) mw = (j == D.NT - 1) ? D.lastmask : ~0ull;
            if (j < D.nvis) {
                const int b = j & 1;
                f32x16 p0, p1;
                {
                    LAS const unsigned char* kb = lds + L_KN + b * 16384 + kq;
                    constexpr int NSTEP = KIND == 0 ? 12 : 8;
                    bf16x8 ka0, ka1, kb0, kb1;
    #define KLOAD(d0_, X0, X1) do { if ((d0_) < 8) { const unsigned off_ = kt ^ (unsigned)((d0_) << 5); X0 = *(LAS const bf16x8*)(kb + off_); X1 = *(LAS const bf16x8*)(kb + 8192 + off_); } \
            else { LAS const unsigned char* kr_ = lds + L_KR + b * 8192 + krq; const unsigned off_ = krt ^ (unsigned)(((d0_) - 8) << 5); X0 = *(LAS const bf16x8*)(kr_ + off_); X1 = *(LAS const bf16x8*)(kr_ + 4096 + off_); } } while (0)
                    KLOAD(0, ka0, ka1);
    #pragma unroll
                    for (int d0 = 0; d0 < NSTEP; d0 += 2) {
                        KLOAD(d0 + 1, kb0, kb1);
                        if (d0 == 0) { p0 = __builtin_amdgcn_mfma_f32_32x32x16_bf16(ka0, qr[0], negm, 0, 0, 0); p1 = __builtin_amdgcn_mfma_f32_32x32x16_bf16(ka1, qr[0], negm, 0, 0, 0); }
                        else { p0 = __builtin_amdgcn_mfma_f32_32x32x16_bf16(ka0, qr[d0], p0, 0, 0, 0); p1 = __builtin_amdgcn_mfma_f32_32x32x16_bf16(ka1, qr[d0], p1, 0, 0, 0); }
                        SBAR();
                        if (d0 + 2 < NSTEP) KLOAD(d0 + 2, ka0, ka1);
                        p0 = __builtin_amdgcn_mfma_f32_32x32x16_bf16(kb0, qr[d0 + 1], p0, 0, 0, 0); p1 = __builtin_amdgcn_mfma_f32_32x32x16_bf16(kb1, qr[d0 + 1], p1, 0, 0, 0); SBAR();
                    }
    #undef KLOAD
                }
                float pmax = fmaxf(fmaxf(p0[0], p0[1]), p0[2]);
    #pragma unroll
                for (int r = 3; r < 15; r += 2) pmax = fmaxf(fmaxf(pmax, p0[r]), p0[r + 1]);
                pmax = fmaxf(pmax, p0[15]);
    #pragma unroll
                for (int r = 0; r < 16; r += 2) pmax = fmaxf(fmaxf(pmax, p1[r]), p1[r + 1]);
                { auto rr = __builtin_amdgcn_permlane32_swap(__float_as_uint(pmax), __float_as_uint(pmax), false, false); pmax = fmaxf(__uint_as_float(rr[0]), __uint_as_float(rr[1])); }
                float alpha = 1.f;
                if (!__all(pmax <= 8.0f)) {
                    const float d = fmaxf(pmax, 0.f); alpha = __builtin_amdgcn_exp2f(-d);
    #pragma unroll
                    for (int r = 0; r < 16; ++r) { p0[r] -= d; p1[r] -= d; negm[r] -= d; }
                }
                float ps = 0.f;
    #pragma unroll
                for (int r = 0; r < 16; ++r) { p0[r] = __builtin_amdgcn_exp2f(p0[r]); p1[r] = __builtin_amdgcn_exp2f(p1[r]); }
                if (KIND == 1 || mw != ~0ull) {
                    const unsigned lo = (unsigned)mw >> (4 * hi), hh = (unsigned)(mw >> 32) >> (4 * hi);
    #pragma unroll
                    for (int r = 0; r < 16; ++r) { const int bit = (r & 3) + 8 * (r >> 2);
                        p0[r] = __uint_as_float(__float_as_uint(p0[r]) & (unsigned)__builtin_amdgcn_sbfe((int)lo, bit, 1));
                        p1[r] = __uint_as_float(__float_as_uint(p1[r]) & (unsigned)__builtin_amdgcn_sbfe((int)hh, bit, 1)); }
                }
    #pragma unroll
                for (int r = 0; r < 16; ++r) ps += p0[r] + p1[r];
                { auto rr = __builtin_amdgcn_permlane32_swap(__float_as_uint(ps), __float_as_uint(ps), false, false); ps = __uint_as_float(rr[0]) + __uint_as_float(rr[1]); }
                l_reg = l_reg * alpha + ps;
                bf16x8 pa0, pa1, pa2, pa3;
    #define PK4(P, BASE, OUT) do { unsigned a0 = cvtpk(P[BASE + 0], P[BASE + 1]), a1 = cvtpk(P[BASE + 2], P[BASE + 3]); \
        unsigned b0 = cvtpk(P[BASE + 4], P[BASE + 5]), b1 = cvtpk(P[BASE + 6], P[BASE + 7]); \
        auto r0 = __builtin_amdgcn_permlane32_swap(a0, b0, false, false); auto r1 = __builtin_amdgcn_permlane32_swap(a1, b1, false, false); \
        u32x4 w = {r0[0], r1[0], r0[1], r1[1]}; OUT = __builtin_bit_cast(bf16x8, w); } while (0)
                PK4(p0, 0, pa0); PK4(p0, 8, pa1); PK4(p1, 0, pa2); PK4(p1, 8, pa3);
    #undef PK4
                if (__any(alpha < 1.f)) {
                    if (hi == 0) wsf[32 + r32] = alpha;
                    asm volatile("s_waitcnt lgkmcnt(0)" ::: "memory");
    #pragma unroll
                    for (int r = 0; r < 16; ++r) { const float a = wsf[32 + crow(r, hi)];
    #pragma unroll
                        for (int d = 0; d < 4; ++d) o[d][r] *= a; }
                }
                const unsigned vb = vb0 + (unsigned)((j % 3) * 16384);
                pv_all(o, vb, pa0, pa1, pa2, pa3);
            }
        }

#undef STAGE
        lf = l_reg;
#pragma unroll
        for (int d = 0; d < 4; ++d) of[d] = o[d];
        asm volatile("s_waitcnt vmcnt(0) lgkmcnt(0)" ::: "memory"); BAR();
    }
    if (active) {
        if (hi == 0) wsf[r32] = lf;
        asm volatile("s_waitcnt lgkmcnt(0)" ::: "memory");
        LAS unsigned char* ost = lds + wid * 8192;
#pragma unroll
        for (int r = 0; r < 16; ++r) { const float rl = __builtin_amdgcn_rcpf(wsf[crow(r, hi)]); const int row = crow(r, hi);
#pragma unroll
            for (int d = 0; d < 4; ++d) *(LAS unsigned short*)(ost + row * 256 + (32 * d + r32) * 2) = (unsigned short)f2bf(of[d][r] * rl); }
        asm volatile("s_waitcnt lgkmcnt(0)" ::: "memory");
#pragma unroll
        for (int i = 0; i < 8; ++i) {
            const int lr = 4 * i + (lane >> 4), cc = (lane & 15) * 8;
            if (lr < D.nvalid) {
                const bf16x8 ov = *(LAS const bf16x8*)(ost + lr * 256 + cc * 2);
                const size_t idx = (size_t)(D.tok0 + (lr & D.tmask)) * 4096 + D.hcol0 + (lr >> D.hshift) * 128 + cc;
                const bf16x8 g = *(const bf16x8*)(GATE + idx);
                bf16x8 ab; if constexpr (KIND == 1) ab = *(const bf16x8*)(ADDB + idx);
                u32x4 w;
#pragma unroll
                for (int e = 0; e < 4; ++e) {
                    float x0 = bf2f((unsigned short)ov[2 * e]) * bf2f((unsigned short)g[2 * e]), x1 = bf2f((unsigned short)ov[2 * e + 1]) * bf2f((unsigned short)g[2 * e + 1]);
                    if constexpr (KIND == 1) { x0 += bf2f((unsigned short)ab[2 * e]); x1 += bf2f((unsigned short)ab[2 * e + 1]); }
                    w[e] = pk2(x0, x1);
                }
                *(u32x4*)(OUT + idx) = w;
            }
        }
    }
}

__device__ __forceinline__ void idx_unit(LAS unsigned char* lds, const bf16* QI, const float* WI, const bf16* KI, int tok0, int NT, int nvalid, float* srow0, size_t spitch, int wid, int lane) {
    asm volatile("" : "+v"(lane));
    const int r32 = lane & 31, hi = lane >> 5;
    asm volatile("s_waitcnt vmcnt(0) lgkmcnt(0)" ::: "memory"); BAR();
    bf16x8 qa[2][8]; float wv[2][16];
#pragma unroll
    for (int t = 0; t < 2; ++t) { const int tok = tok0 + 2 * wid + t; const bf16* qp = QI + (size_t)tok * 4096 + r32 * 128 + hi * 8;
#pragma unroll
        for (int d0 = 0; d0 < 8; ++d0) qa[t][d0] = *(const bf16x8*)(qp + d0 * 16);
#pragma unroll
        for (int r = 0; r < 16; ++r) wv[t][r] = WI[(size_t)tok * 32 + crow(r, hi)]; }
    int kn_off[2];
#pragma unroll
    for (int i = 0; i < 2; ++i) { const int row = 8 * wid + 4 * i + (lane >> 4), chunk = (lane & 15) ^ (row & 15); kn_off[i] = row * 128 + chunk * 8; }
#define ISTAGE2(J, b) do { const bf16* kb_ = KI + (size_t)(J) * 128 * 128; glds(kb_ + kn_off[0], lds + (b) * 32768 + (2 * wid) * 1024); glds(kb_ + kn_off[1], lds + (b) * 32768 + (2 * wid + 1) * 1024); \
        if (2 * (J) + 1 < NT) { glds(kb_ + 8192 + kn_off[0], lds + (b) * 32768 + 16384 + (2 * wid) * 1024); glds(kb_ + 8192 + kn_off[1], lds + (b) * 32768 + 16384 + (2 * wid + 1) * 1024); } } while (0)
    const unsigned kq = (unsigned)(r32 * 256), kt = (unsigned)((hi ^ (r32 & 15)) << 4);
    float* s0 = srow0 + (size_t)(2 * wid) * spitch; float* s1 = s0 + spitch;
    const int NS2 = (NT + 1) >> 1;
    ISTAGE2(0, 0);
    for (int J = 0; J < NS2; ++J) {
        if (J == 0) asm volatile("s_waitcnt vmcnt(0)" ::: "memory");
        else asm volatile("s_waitcnt vmcnt(4)" ::: "memory");
        BAR();
        if (J + 1 < NS2) ISTAGE2(J + 1, (J + 1) & 1);
        const int nq = (2 * J + 1 < NT) ? 4 : 2;
        const unsigned kba = (unsigned)(size_t)(lds + (J & 1) * 32768 + kq);
        bf16x8 kfa[8], kfb[8];
        float sc[2][4];
#define IREAD(KF, Q) do { _Pragma("unroll") for (int d0 = 0; d0 < 8; ++d0) asm volatile("ds_read_b128 %0, %1 offset:%2" : "=v"(KF[d0]) : "v"(kba + (kt ^ (unsigned)(d0 << 5))), "i"((Q) * 8192) : "memory"); } while (0)
#define IMMA(ACC, KF, T) do { _Pragma("unroll") for (int r = 0; r < 16; ++r) ACC[r] = 0.f; __builtin_amdgcn_s_setprio(1); \
            _Pragma("unroll") for (int d0 = 0; d0 < 8; ++d0) ACC = __builtin_amdgcn_mfma_f32_32x32x16_bf16(qa[T][d0], KF[d0], ACC, 0, 0, 0); __builtin_amdgcn_s_setprio(0); } while (0)
#define IRED(ACC, T, Q) do { float s_ = 0.f; \
            _Pragma("unroll") for (int r = 0; r < 16; ++r) s_ += __builtin_amdgcn_fmed3f(ACC[r], 0.f, 3.0e38f) * wv[T][r]; \
            auto rr_ = __builtin_amdgcn_permlane32_swap(__float_as_uint(s_), __float_as_uint(s_), false, false); \
            sc[T][Q] = __uint_as_float(rr_[0]) + __uint_as_float(rr_[1]); } while (0)
        f32x16 accA, accB;
        IREAD(kfa, 0);
        IREAD(kfb, 1); asm volatile("s_waitcnt lgkmcnt(8)" ::: "memory"); SBAR();
        IMMA(accA, kfa, 0); SBAR();
        IMMA(accB, kfa, 1); IRED(accA, 0, 0); SBAR();
        if (nq == 4) { IREAD(kfa, 2); asm volatile("s_waitcnt lgkmcnt(8)" ::: "memory"); } else asm volatile("s_waitcnt lgkmcnt(0)" ::: "memory");
        SBAR();
        IMMA(accA, kfb, 0); IRED(accB, 1, 0); SBAR();
        IMMA(accB, kfb, 1); IRED(accA, 0, 1); SBAR();
        if (nq == 4) {
            IREAD(kfb, 3); asm volatile("s_waitcnt lgkmcnt(8)" ::: "memory"); SBAR();
            IMMA(accA, kfa, 0); IRED(accB, 1, 1); SBAR();
            {
                const int j = 2 * J; const bool kv = j * 64 + lane < nvalid;
                s0[j * 64 + lane] = kv ? (hi ? sc[0][1] : sc[0][0]) : -INFINITY;
                s1[j * 64 + lane] = kv ? (hi ? sc[1][1] : sc[1][0]) : -INFINITY;
            }
            IMMA(accB, kfa, 1); IRED(accA, 0, 2); SBAR();
            asm volatile("s_waitcnt lgkmcnt(0)" ::: "memory"); SBAR();
            IMMA(accA, kfb, 0); IRED(accB, 1, 2); SBAR();
            IMMA(accB, kfb, 1); IRED(accA, 0, 3); SBAR();
            IRED(accB, 1, 3);
            const int j = 2 * J + 1; const bool kv = j * 64 + lane < nvalid;
            s0[j * 64 + lane] = kv ? (hi ? sc[0][3] : sc[0][2]) : -INFINITY;
            s1[j * 64 + lane] = kv ? (hi ? sc[1][3] : sc[1][2]) : -INFINITY;
        } else {
            IRED(accB, 1, 1);
            const int j = 2 * J; const bool kv = j * 64 + lane < nvalid;
            s0[j * 64 + lane] = kv ? (hi ? sc[0][1] : sc[0][0]) : -INFINITY;
            s1[j * 64 + lane] = kv ? (hi ? sc[1][1] : sc[1][0]) : -INFINITY;
        }
    }
#undef IMMA
#undef IRED
#undef IREAD
#undef ISTAGE2
    for (int j = NT * 64 + lane; j < (int)spitch; j += 64) { s0[j] = -INFINITY; s1[j] = -INFINITY; }
}

__device__ __forceinline__ unsigned okey(float f) { const unsigned u = __float_as_uint(f); return (u & 0x80000000u) ? ~u : (u | 0x80000000u); }
template <int NS> __device__ __forceinline__ void topk_wave(const float* srow, u64* mrow, int lane) {
    asm volatile("" : "+v"(lane));
    unsigned key[NS];
    {
        unsigned long long base = (unsigned long long)srow;
#pragma unroll
        for (int j0 = 0; j0 < NS; j0 += 16) {
            asm volatile("" : "+s"(base));
            const float* b = (const float*)base + lane;
#pragma unroll
            for (int jj = 0; jj < 16; ++jj) key[j0 + jj] = okey(b[jj * 64]);
            base += 4096;
        }
    }
    unsigned T = 0u; bool exact = false;
    for (int bit = 31; bit >= 0; --bit) {
        const unsigned cand = T | (1u << bit); unsigned tot = 0;
#pragma unroll
        for (int j = 0; j < NS; ++j) { tot += (unsigned)__builtin_popcountll(__ballot(key[j] >= cand)); if ((j & 7) == 7) SBAR(); }
        if (tot >= 256u) T = cand;
        if (tot == 256u) { exact = true; break; }
    }
    T = (unsigned)__builtin_amdgcn_readfirstlane((int)T);
    if (exact) {
        u64* mp = mrow; asm volatile("" : "+v"(mp));
#pragma unroll
        for (int j = 0; j < NS; ++j) { const u64 m = __ballot(key[j] >= T); if (lane == 0) mp[j] = m; if ((j & 3) == 3) SBAR(); }
    } else {
        unsigned gt = 0;
        for (int j = 0; j < NS; ++j) gt += (unsigned)__builtin_popcountll(__ballot(okey(srow[64 * j + lane]) > T));
        int need = 256 - (int)gt;
        for (int j = 0; j < NS; ++j) {
            const unsigned k = okey(srow[64 * j + lane]); const u64 g = __ballot(k > T); u64 e = __ballot(k == T);
            while ((int)__builtin_popcountll(e) > need) e &= ~(1ull << (63 - __builtin_clzll(e)));
            need -= (int)__builtin_popcountll(e);
            if (lane == 0) mrow[j] = g | e;
        }
    }
}
__device__ __forceinline__ void topk_row_wave(const float* srow, int n, int pitch, u64* mrow, int lane) {
    if (n <= 256) { const int nt = (n + 63) >> 6; if (lane < nt) mrow[lane] = ~0ull; return; }
    if (pitch == 1024) topk_wave<16>(srow, mrow, lane);
    else if (pitch == 2048) topk_wave<32>(srow, mrow, lane);
    else if (pitch == 4096) topk_wave<64>(srow, mrow, lane);
    else topk_wave<128>(srow, mrow, lane);
}
#undef SBAR
#undef BAR
}

__device__ const unsigned short IDX_UNITS[512] = {2, 451, 3, 452, 1, 448, 0, 450, 42, 411, 33, 416, 104, 343, 18, 434, 74, 375, 4, 442, 70, 378, 11, 441, 77, 369, 14, 437, 120, 325, 94, 353, 13, 507, 16, 501, 15, 506, 9, 504, 8, 505, 5, 509, 23, 496, 6, 508, 27, 495, 34, 487, 12, 503, 30, 488, 21, 497, 19, 502, 7, 511, 20, 499, 36, 482, 43, 476, 38, 481, 31, 490, 45, 474, 24, 492, 55, 469, 10, 510, 25, 493, 29, 491, 53, 466, 72, 444, 58, 463, 61, 457, 44, 477, 51, 472, 17, 500, 39, 484, 41, 480, 46, 479, 63, 459, 26, 494, 54, 467, 50, 475, 62, 461, 52, 470, 47, 473, 56, 464, 59, 462, 35, 486, 71, 449, 65, 458, 22, 498, 57, 465, 28, 489, 48, 468, 60, 460, 37, 483, 40, 478, 32, 485, 49, 471, 66, 456, 73, 447, 79, 443, 67, 453, 69, 454, 82, 439, 64, 455, 76, 438, 68, 445, 75, 446, 78, 440, 81, 435, 91, 427, 80, 436, 87, 433, 84, 430, 88, 425, 90, 431, 95, 421, 93, 423, 83, 432, 96, 417, 86, 429, 107, 414, 92, 426, 89, 424, 99, 420, 100, 419, 103, 415, 98, 422, 101, 413, 109, 406, 97, 418, 102, 412, 106, 410, 110, 407, 111, 409, 105, 408, 108, 405, 115, 403, 85, 428, 114, 400, 112, 404, 130, 389, 121, 397, 118, 401, 117, 398, 113, 402, 129, 390, 126, 393, 116, 399, 124, 391, 119, 396, 123, 392, 122, 394, 131, 385, 133, 382, 125, 395, 127, 388, 132, 386, 137, 383, 135, 384, 128, 387, 134, 381, 139, 380, 143, 374, 140, 373, 138, 379, 142, 376, 136, 377, 150, 364, 149, 365, 147, 370, 146, 371, 156, 359, 148, 366, 145, 367, 153, 361, 141, 372, 144, 368, 157, 357, 155, 363, 154, 362, 163, 349, 159, 356, 164, 346, 151, 360, 162, 352, 152, 358, 170, 345, 174, 342, 167, 350, 166, 347, 165, 348, 160, 354, 158, 355, 169, 340, 161, 351, 171, 344, 178, 337, 173, 339, 172, 336, 168, 341, 181, 333, 179, 332, 175, 338, 176, 335, 182, 330, 180, 328, 183, 329, 177, 334, 185, 326, 186, 331, 187, 324, 184, 327, 189, 321, 190, 323, 188, 322, 191, 320, 192, 317, 194, 319, 195, 318, 193, 316, 199, 312, 198, 313, 196, 315, 197, 314, 200, 309, 203, 311, 201, 310, 202, 308, 204, 304, 206, 306, 207, 305, 205, 307, 209, 303, 208, 302, 210, 301, 211, 300, 215, 299, 214, 297, 213, 298, 212, 296, 217, 293, 219, 294, 216, 295, 218, 292, 221, 289, 223, 290, 222, 291, 220, 288, 227, 285, 225, 284, 226, 286, 224, 287, 230, 281, 229, 283, 231, 282, 228, 280, 235, 276, 233, 278, 234, 279, 232, 277, 236, 274, 237, 272, 238, 273, 239, 275, 243, 269, 242, 270, 241, 268, 240, 271, 246, 264, 244, 265, 247, 267, 245, 266, 251, 263, 248, 260, 249, 262, 250, 261, 252, 256, 253, 257, 255, 258, 254, 259};
__device__ __forceinline__ void p5_mla_and_indexer(const Ctx& C) {
    unsigned char* ws = C.ws; const int w = C.wave;
    const bf16* QAN = (const bf16*)(ws + WS_QAN); const bf16* QAR = (const bf16*)(ws + WS_QAR); const bf16* KN = (const bf16*)(ws + WS_KN); const bf16* VM = (const bf16*)(ws + WS_VM);
    const bf16* KRP = (const bf16*)(ws + WS_KROPE); const bf16* SGA = (const bf16*)(ws + WS_SGA); bf16* OUTA = (bf16*)(ws + WS_OUTA);
    const bf16* QI = (const bf16*)(ws + WS_QI); const bf16* KI = (const bf16*)(ws + WS_KI); const float* WI = (const float*)(ws + WS_WI); float* SC = (float*)(ws + WS_SCORE);
    for (int v = C.bx; v < 256; v += C.G) {
        const int x = v & 7, jj = v >> 3;
        for (int k = 0; k < 4; ++k) {
            const int h = x + 8 * k, qb = (k & 1) ? 31 - jj : jj;
            att::Desc D; D.K = KN + h * 128; D.ldk = 4096; D.Kr = KRP; D.V = VM + h * 128; D.ldv = 4096; D.NT = 4 * (qb + 1); D.nvis = 4 * qb + (w >> 1) + 1; D.lastmask = ~0ull;
            D.tok0 = 256 * qb + 32 * w; D.tmask = 31; D.hshift = 5; D.hcol0 = h * 128; D.nvalid = 32;
            att::attn_unit<0>(C.lds, D, QAN, QAR, nullptr, SGA, nullptr, OUTA, w, C.lane);
        }
        for (int k = 0; k < 2; ++k) {
            const int su = v + 256 * k, b = su >> 5, h = su & 31; const size_t kr0 = (size_t)SEQ + (size_t)b * SPITCH;
            att::Desc D; D.K = KN + kr0 * 4096 + h * 128; D.ldk = 4096; D.Kr = KRP + kr0 * 64; D.V = VM + kr0 * 4096 + h * 128; D.ldv = 4096; D.NT = 17; D.nvis = (w == 0) ? 17 : 0; D.lastmask = 0xFFFFull;
            D.tok0 = SEQ + 16 * b; D.tmask = 15; D.hshift = 5; D.hcol0 = h * 128; D.nvalid = 16;
            att::attn_unit<0>(C.lds, D, QAN, QAR, nullptr, SGA, nullptr, OUTA, w, C.lane);
        }
    }
    for (int v = C.bx; v < 256; v += C.G) {
        for (int k = 0; k < 2; ++k) {
            const int un = IDX_UNITS[v * 2 + k], c = un >> 2, tg = un & 3; const size_t pitch = (size_t)score_pitch(c);
            att::idx_unit(C.lds, QI, WI, KI, 64 * c + 16 * tg, c + 1, 64 * (c + 1), SC + score_chunk_off(c) + (size_t)(16 * tg) * pitch, pitch, w, C.lane);
        }
        if (v < DEC_B) att::idx_unit(C.lds, QI, WI, KI + ((size_t)SEQ + (size_t)v * SPITCH) * 128, SEQ + 16 * v, 17, SKEYS, SC + SCORE_P_FLOATS + (size_t)(16 * v) * SPITCH_SC, SPITCH_SC, w, C.lane);
    }
    asm volatile("s_waitcnt vmcnt(0) lgkmcnt(0)" ::: "memory"); __syncthreads();
}
__device__ __forceinline__ void p6_topk(const Ctx& C) {
    const float* SC = (const float*)(C.ws + WS_SCORE); att::u64* MASK = (att::u64*)(C.ws + WS_MASK);
    const int gw = C.bx * NWAVES + C.wave, NGW = C.G * NWAVES;
    for (int r = gw; r < NROW; r += NGW) {
        int n, pitch; const float* srow;
        if (r < SEQ) { const int c = r >> 6; n = 64 * (c + 1); pitch = score_pitch(c); srow = SC + score_chunk_off(c) + (size_t)(r & 63) * pitch; }
        else { n = SKEYS; pitch = SPITCH_SC; srow = SC + SCORE_P_FLOATS + (size_t)(r - SEQ) * SPITCH_SC; }
        att::topk_row_wave(srow, n, pitch, MASK + (size_t)r * 128, C.lane);
    }
}
__device__ const unsigned char DSA_CHUNKS[128] = {1, 115, 63, 66, 2, 118, 64, 61, 0, 110, 60, 75, 12, 104, 62, 68, 3, 119, 57, 67, 13, 102, 58, 73, 6, 124, 56, 59, 8, 100, 65, 72, 7, 117, 52, 69, 9, 114, 53, 70, 5, 123, 46, 71, 4, 126, 38, 77, 11, 105, 55, 74, 15, 107, 42, 81, 14, 103, 49, 80, 16, 96, 54, 79, 10, 120, 51, 82, 17, 121, 48, 76, 18, 111, 50, 84, 19, 127, 31, 86, 25, 116, 44, 78, 20, 125, 29, 89, 22, 113, 41, 87, 23, 112, 43, 85, 21, 109, 37, 95, 28, 122, 30, 83, 26, 99, 45, 92, 24, 101, 47, 91, 27, 108, 35, 93, 39, 97, 33, 94, 32, 106, 36, 88, 40, 98, 34, 90};
__device__ __forceinline__ void p7_dsa(const Ctx& C) {
    unsigned char* ws = C.ws; const int w = C.wave;
    const bf16* QB = (const bf16*)(ws + WS_QB); const bf16* KA = (const bf16*)(ws + WS_KALL); const bf16* VA = (const bf16*)(ws + WS_VALL);
    const att::u64* MASK = (const att::u64*)(ws + WS_MASK); const bf16* SGB = (const bf16*)(ws + WS_SGB); const bf16* OUTA = (const bf16*)(ws + WS_OUTA); bf16* MG = (bf16*)(ws + WS_MERGED);
    for (int v = C.bx; v < 256; v += C.G) {
        const int g = v & 7, jj = v >> 3;
        for (int k = 0; k < 4; ++k) {
            const int c = DSA_CHUNKS[jj * 4 + k];
            att::Desc D; D.K = KA + g * 128; D.ldk = 1024; D.Kr = nullptr; D.V = VA + g * 128; D.ldv = 1024; D.NT = c + 1; D.nvis = c + 1; D.lastmask = ~0ull;
            D.tok0 = 64 * c + 32 * (w & 1); D.tmask = 31; D.hshift = 5; D.hcol0 = (4 * g + (w >> 1)) * 128; D.nvalid = 32;
            att::attn_unit<1>(C.lds, D, QB, nullptr, MASK, SGB, OUTA, MG, w, C.lane);
        }
        if (v < DEC_B * NKV) {
            const int b = v >> 3; const size_t kr0 = (size_t)SEQ + (size_t)b * SPITCH;
            att::Desc D; D.K = KA + kr0 * 1024 + g * 128; D.ldk = 1024; D.Kr = nullptr; D.V = VA + kr0 * 1024 + g * 128; D.ldv = 1024; D.NT = 17; D.nvis = (w < 2) ? 17 : 0; D.lastmask = ~0ull;
            D.tok0 = SEQ + 16 * b; D.tmask = 15; D.hshift = 4; D.hcol0 = (4 * g + 2 * w) * 128; D.nvalid = 32;
            att::attn_unit<1>(C.lds, D, QB, nullptr, MASK, SGB, OUTA, MG, w, C.lane);
        }
    }
    asm volatile("s_waitcnt vmcnt(0) lgkmcnt(0)" ::: "memory"); __syncthreads();
}


constexpr int N_PHASES = 13;
__global__ void __launch_bounds__(NWAVES * 64, 2) fwd_kernel(Args args) {
    extern __shared__ __attribute__((aligned(16))) unsigned char lds_raw[];
    Ctx C; C.lds = (LAS unsigned char*)lds_raw; C.a = &args; C.ws = args.ws; C.out = args.out;
    C.tid = threadIdx.x; C.lane = C.tid & 63; C.wave = __builtin_amdgcn_readfirstlane(C.tid >> 6); C.G = gridDim.x; C.bx = blockIdx.x;
    volatile LAS unsigned* MISC = (volatile LAS unsigned*)(C.lds + MISC_OFF);
    for (int u = C.tid; u < (LDS_BYTES - LDSCTL_OFF) / 4; u += NWAVES * 64) ((LAS unsigned*)(C.lds + LDSCTL_OFF))[u] = 0u;
    __syncthreads();
    unsigned* ctl = (unsigned*)(args.ws + WS_CTL);
    XcdBarrier bar; bar.bar = ctl + CW_BAR; bar.x = 0; bar.st = nullptr;
    if (MK_N_LAUNCHES == 1) bar = xcd_barrier_post(ctl + CW_BAR, MISC + 8);
    const int lo = args.ph_lo, hi = args.ph_hi;
#ifndef PH_MASK
#define PH_MASK 0xFFFFFFFFu
#endif
#define IN(k) (((PH_MASK >> (k)) & 1) && lo <= (k) && (k) < hi)
#define SEAM(k) do { if (IN(k) && IN((k) + 1)) xcd_barrier(bar); } while (0)
    unsigned char* ws = args.ws;
    PG8_LAS unsigned char* ring = (PG8_LAS unsigned char*)lds_raw;

    if (IN(0)) { p01_gemv_and_copies(C); SEAM(0); }
    if (IN(1)) { p1_modnorm(C); SEAM(1); }
    if (IN(2)) {
        pg8::Gemm g{(const pg8::bf16_t*)(ws + WS_XN), (const pg8::bf16_t*)(ws + WS_WIN), NROW, DINP, DM}; pg8::StaticOrder S; S.init(NROW, DINP, C.G, C.bx);
        const float* rp = (const float*)(ws + WS_ROPE);
        pg8::EpiIn E{(float*)(ws + WS_QRAW), (float*)(ws + WS_CKVRAW), (pg8::bf16_t*)(ws + WS_QB), (pg8::bf16_t*)(ws + WS_QI), (pg8::bf16_t*)(ws + WS_SGA), (pg8::bf16_t*)(ws + WS_SGB),
                     (pg8::bf16_t*)(ws + WS_KALL), (pg8::bf16_t*)(ws + WS_VALL), (pg8::bf16_t*)(ws + WS_KI), (pg8::bf16_t*)(ws + WS_KROPE), (float*)(ws + WS_WI), args.out,
                     rp, rp + SEQ * 32, rp + SEQ * 64, rp + SEQ * 64 + SEQ * 16};
        S.lim = (S.nwg / C.G) * C.G;
        pg8::gemm_phase<pg8::EpiIn, pg8::StaticOrder, true, true>(ring, g, S, E);
        { pg8::TailHalfOrder T; T.init(NROW, DINP, C.G, C.bx); pg8::gemm_phase<pg8::EpiIn, pg8::TailHalfOrder, true, true, true>(ring, g, T, E); }
        SEAM(2);
    }
    if (IN(3)) { p3_norms(C); SEAM(3); }
    if (IN(4)) {
        {
            pg8::Gemm g{(const pg8::bf16_t*)(ws + WS_QN), (const pg8::bf16_t*)(ws + WS_WUQ), NROW, 6144, QLORA}; pg8::StaticOrder S; S.init(NROW, 6144, C.G, C.bx);
            const float* rp = (const float*)(ws + WS_ROPE);
            pg8::EpiUq E{(pg8::bf16_t*)(ws + WS_QAN), (pg8::bf16_t*)(ws + WS_QAR), rp, rp + SEQ * 32};
            pg8::gemm_phase<pg8::EpiUq, pg8::StaticOrder, true, true>(ring, g, S, E);
        }
        {
            pg8::Gemm g{(const pg8::bf16_t*)(ws + WS_CKV), (const pg8::bf16_t*)(ws + WS_WUKV), KROWS, 8192, KVLORA}; pg8::StaticOrder S; S.init(KROWS, 8192, C.G, (C.bx + C.G / 2) % C.G);
            pg8::EpiBf16<0> E{(pg8::bf16_t*)(ws + WS_KN), 4096, 4096, (WS_VM - WS_KN) / 2};
            pg8::gemm_phase<pg8::EpiBf16<0>, pg8::StaticOrder, true, true>(ring, g, S, E);
        }
        SEAM(4);
    }
    if (IN(5)) { p5_mla_and_indexer(C); SEAM(5); }
    if (IN(6)) { p6_topk(C); SEAM(6); }
    if (IN(7)) { p7_dsa(C); SEAM(7); }
    if (IN(8)) {
        pg8::Gemm g{(const pg8::bf16_t*)(ws + WS_MERGED), (const pg8::bf16_t*)(ws + WS_WOUT), NROW, DM, DM}; pg8::SampleSplitOrder S; S.init(SEQ, DM, DM, SPLIT_OUT, C.G, C.bx);
        pg8::EpiRes E{args.in[I_XP], args.in[I_XS], args.out + O_Y, (const float*)(ws + WS_ADA) + 2 * DM, (float*)(ws + WS_SLAB)};
        pg8::gemm_phase<pg8::EpiRes, pg8::SampleSplitOrder, true, true>(ring, g, S, E);
        SEAM(8);
    }
    if (IN(9)) { p9_h2(C); SEAM(9); }
    if (IN(10)) {
        pg8::Gemm g{(const pg8::bf16_t*)(ws + WS_XN), (const pg8::bf16_t*)(ws + WS_WUP), NROW, DFF, DM}; pg8::StaticOrder S; S.init(NROW, DFF, C.G, C.bx);
        pg8::EpiBf16<2> E{(pg8::bf16_t*)(ws + WS_U), DFF, 0, 0};
        S.lim = (S.nwg / C.G) * C.G;
        pg8::gemm_phase<pg8::EpiBf16<2>, pg8::StaticOrder, true, true>(ring, g, S, E);
        { pg8::TailHalfOrder T; T.init(NROW, DFF, C.G, C.bx); pg8::gemm_phase<pg8::EpiBf16<2>, pg8::TailHalfOrder, true, true, true>(ring, g, T, E); }
        SEAM(10);
    }
    if (IN(11)) {
        pg8::Gemm g{(const pg8::bf16_t*)(ws + WS_U), (const pg8::bf16_t*)(ws + WS_WDOWN), NROW, DM, DFF}; pg8::SampleSplitOrder S; S.init(SEQ, DM, DFF, SPLIT_DOWN, C.G, C.bx);
        pg8::EpiRes E{args.out + O_Y, args.out + O_Y + (size_t)SEQ * DM, args.out + O_Y, (const float*)(ws + WS_ADA) + 5 * DM, (float*)(ws + WS_SLAB)};
        pg8::gemm_phase<pg8::EpiRes, pg8::SampleSplitOrder, true, true>(ring, g, S, E);
        SEAM(11);
    }
    if (IN(12)) { p12_final(C); }
#undef IN
#undef SEAM
}

extern "C" void kernel_launch(void* const* d_in, const int* in_sizes, int n_in, void* d_out, int out_size, void* d_ws, size_t ws_size, hipStream_t stream) {
    static int grid = 0;
    if (grid == 0) {
        if (n_in != N_IN || in_sizes[I_XP] != SEQ * DM || in_sizes[I_WIN] != DM * DIN || (size_t)out_size != O_END || ws_size < WS_END) {
            fprintf(stderr, "kernel_launch: shape mismatch (n_in %d, out %d, ws %zu, need ws >= %zu); nothing launched\n", n_in, out_size, ws_size, (size_t)WS_END); grid = -1; return; }
        int dev = 0, cus = 0, per_cu = 0;
        if (hipGetDevice(&dev) != hipSuccess || hipDeviceGetAttribute(&cus, hipDeviceAttributeMultiprocessorCount, dev) != hipSuccess) { grid = -1; return; }
        if (hipFuncSetAttribute((const void*)fwd_kernel, hipFuncAttributeMaxDynamicSharedMemorySize, LDS_BYTES) != hipSuccess) { fprintf(stderr, "kernel_launch: hipFuncSetAttribute failed\n"); grid = -1; return; }
        if (hipOccupancyMaxActiveBlocksPerMultiprocessor(&per_cu, (const void*)fwd_kernel, NWAVES * 64, LDS_BYTES) != hipSuccess || per_cu < 1) { fprintf(stderr, "kernel_launch: occupancy query says %d\n", per_cu); }
        (void)hipGetLastError();
        grid = cus;
    }
    if (grid < 0) return;
    (void)hipMemsetAsync((char*)d_ws + WS_CTL, 0, CTL_ZERO_BYTES, stream);
    Args a{};
    for (int i = 0; i < N_IN; ++i) a.in[i] = (const float*)d_in[i];
    a.out = (float*)d_out; a.ws = (unsigned char*)d_ws;
    if (MK_N_LAUNCHES == 1) { a.ph_lo = 0; a.ph_hi = N_PHASES; a.li = 0; hipLaunchKernelGGL(fwd_kernel, dim3(grid), dim3(NWAVES * 64), LDS_BYTES, stream, a); }
    else {
        const int order[13] = {0, 1, 2, 3, 4, 5, 6, 7, 8, 9, 10, 11, 12};
        for (int q = 0; q < N_PHASES; ++q) { const int p = order[q]; a.ph_lo = p; a.ph_hi = p + 1; a.li = p; hipLaunchKernelGGL(fwd_kernel, dim3(grid), dim3(NWAVES * 64), LDS_BYTES, stream, a); }
    }
    const hipError_t le = hipPeekAtLastError();
    if (le != hipSuccess) fprintf(stderr, "kernel_launch: launch failed: %s\n", hipGetErrorName(le));
}
```
